# Optimizing an MI355X kernel written in HIP

```python
import math
import jax, jax.numpy as jnp
from jax import lax
import numpy as np

D_MODEL = 1024
BATCH = 8
SEQ = 2048
DEPTH = 2
DEC_BATCH = 128
DEC_SEQ = 1
PAST_LEN = 8192
PAGE_SIZE = 128

SSM_CH_PER_GROUP = 16
SSM_GROUPS = 24
SSM_WIDTH = SSM_GROUPS * SSM_CH_PER_GROUP
SSM_STATE = 64
SSM_DT_MIN = 0.001
SSM_DT_MAX = 0.1
RET_HEADS = 4
RET_DK = 64
RET_DV = 64
RET_WIDTH = RET_HEADS * RET_DV
RET_CHUNK = 128
ATT_Q_HEADS = 6
ATT_KV_HEADS = 2
ATT_HEAD_DIM = 64
ATT_WIDTH = ATT_Q_HEADS * ATT_HEAD_DIM
WINDOW = 128
MIX_WIDTH = SSM_WIDTH + RET_WIDTH + ATT_WIDTH
IN_WIDTH = SSM_WIDTH + 2 * RET_HEADS * RET_DK + 2 * RET_WIDTH + (ATT_Q_HEADS + 2 * ATT_KV_HEADS) * ATT_HEAD_DIM
FFN_HIDDEN = ((8 * D_MODEL + 3 * 256 - 1) // (3 * 256)) * 256
DEEPNORM_ALPHA = (2 * DEPTH) ** 0.25
DEEPNORM_BETA = (8 * DEPTH) ** -0.25
LN_EPS = 1e-5
NEG_INF = -1e30

kernel_name = 'hymba_s5_retnet_swa_deepnorm_step'


def _split_points():
    sizes = [SSM_WIDTH, RET_HEADS * RET_DK, RET_HEADS * RET_DK, RET_WIDTH, RET_WIDTH,
             ATT_Q_HEADS * ATT_HEAD_DIM, ATT_KV_HEADS * ATT_HEAD_DIM, ATT_KV_HEADS * ATT_HEAD_DIM]
    return [int(v) for v in np.cumsum(sizes)[:-1]]


def _alibi_slopes(n):
    def pow2(k):
        start = 2.0 ** (-8.0 / k)
        return [start ** (i + 1) for i in range(k)]
    if n & (n - 1) == 0:
        sl = pow2(n)
    else:
        c = 2 ** int(math.floor(math.log2(n)))
        sl = pow2(c) + pow2(2 * c)[0::2][: n - c]
    return jnp.asarray(sl, jnp.float32)


def _layernorm(x, g, b):
    xf = x.astype(jnp.float32)
    mu = jnp.mean(xf, -1, keepdims=True)
    var = jnp.mean(jnp.square(xf - mu), -1, keepdims=True)
    return ((xf - mu) * lax.rsqrt(var + LN_EPS) * g.astype(jnp.float32) + b.astype(jnp.float32)).astype(x.dtype)


def _ssm_combine(e1, e2):
    a1, b1 = e1
    a2, b2 = e2
    return a1 * a2, a2 * b1 + b2


def _s5(u, p, l, h0):
    f32 = jnp.float32
    bsz, L, _ = u.shape
    uf = u.astype(f32).reshape(bsz, L, SSM_GROUPS, SSM_CH_PER_GROUP)
    lam = lax.complex(p['ssm_lambda_re'][l].astype(f32), p['ssm_lambda_im'][l].astype(f32))
    step = jnp.exp(p['ssm_log_step'][l].astype(f32))[:, None]
    lam_dt = lam * step
    lam_bar = jnp.exp(lam_dt)
    b_mat = lax.complex(p['ssm_b_re'][l].astype(f32), p['ssm_b_im'][l].astype(f32))
    b_bar = ((lam_bar - 1.0) / lam)[..., None] * b_mat
    bu = jnp.einsum('gph,blgh->blgp', b_bar, uf.astype(jnp.complex64))
    _, h = lax.associative_scan(_ssm_combine, (jnp.broadcast_to(lam_bar, bu.shape), bu), axis=1)
    if h0 is not None:
        t = jnp.arange(1, L + 1, dtype=f32)[:, None, None]
        h = h + jnp.exp(lam_dt[None] * t)[None] * h0[:, None]
    c_mat = lax.complex(p['ssm_c_re'][l].astype(f32), p['ssm_c_im'][l].astype(f32))
    d = p['ssm_d'][l].astype(f32).reshape(SSM_GROUPS, SSM_CH_PER_GROUP)
    y = jnp.einsum('ghp,blgp->blgh', c_mat, h).real + d * uf
    return y.reshape(bsz, L, SSM_WIDTH), h[:, -1]


def _retention(q, k, v, s0):
    f32 = jnp.float32
    bsz, L = q.shape[:2]
    c = math.gcd(L, RET_CHUNK)
    n = L // c
    log_g = jnp.log1p(-(2.0 ** (-5.0 - jnp.arange(RET_HEADS, dtype=f32))))
    idx = jnp.arange(c)
    diff = idx[:, None] - idx[None, :]
    decay_mask = jnp.where(diff >= 0, jnp.exp(log_g[:, None, None] * jnp.maximum(diff, 0).astype(f32)), 0.0)
    inner_decay = jnp.exp(log_g[:, None] * (idx + 1).astype(f32))[None, :, :, None]
    kv_decay = jnp.exp(log_g[:, None] * (c - 1 - idx).astype(f32))[None, :, :, None]
    chunk_decay = jnp.exp(log_g * c)[None, :, None, None]

    def to_chunks(t):
        return t.astype(f32).reshape(bsz, n, c, RET_HEADS, t.shape[-1]).transpose(1, 0, 3, 2, 4)

    def step(s, inp):
        qi, ki, vi = inp
        sc = jnp.einsum('bhqd,bhcd->bhqc', qi, ki) * decay_mask
        o = jnp.einsum('bhqc,bhce->bhqe', sc, vi) + jnp.einsum('bhqd,bhde->bhqe', qi, s) * inner_decay
        s_new = chunk_decay * s + jnp.einsum('bhcd,bhce->bhde', ki * kv_decay, vi)
        return s_new, o

    s_last, o = lax.scan(step, s0, (to_chunks(q), to_chunks(k), to_chunks(v)))
    o = o.transpose(1, 0, 3, 2, 4).reshape(bsz, L, RET_HEADS, RET_DV)
    return o, s_last


def _sink_softmax(s, sink):
    m = jnp.maximum(jnp.max(s, -1, keepdims=True), sink)
    e = jnp.exp(s - m)
    return e / (jnp.sum(e, -1, keepdims=True) + jnp.exp(sink - m))


def _swa_prompt(q, k, v, sinks):
    f32 = jnp.float32
    bsz, L = q.shape[:2]
    nb = L // WINDOW
    grp = ATT_Q_HEADS // ATT_KV_HEADS
    qb = q.astype(f32).reshape(bsz, nb, WINDOW, ATT_KV_HEADS, grp, ATT_HEAD_DIM)

    def with_prev(t):
        tb = t.astype(f32).reshape(bsz, nb, WINDOW, ATT_KV_HEADS, ATT_HEAD_DIM)
        prev = jnp.concatenate([jnp.zeros_like(tb[:, :1]), tb[:, :-1]], axis=1)
        return jnp.concatenate([prev, tb], axis=2)

    kc, vc = with_prev(k), with_prev(v)
    s = jnp.einsum('bnqkgd,bnskd->bnkgqs', qb, kc) * (ATT_HEAD_DIM ** -0.5)
    kpos = jnp.arange(2 * WINDOW)
    dist = (jnp.arange(WINDOW) + WINDOW)[:, None] - kpos[None, :]
    valid = (dist >= 0) & (dist <= WINDOW)
    valid = valid[None] & ((jnp.arange(nb)[:, None, None] > 0) | (kpos[None, None, :] >= WINDOW))
    slopes = _alibi_slopes(ATT_Q_HEADS).reshape(ATT_KV_HEADS, grp)[:, :, None, None]
    s = s - slopes * dist.astype(f32)
    s = jnp.where(valid[None, :, None, None], s, NEG_INF)
    w = _sink_softmax(s, sinks.astype(f32).reshape(ATT_KV_HEADS, grp)[:, :, None, None])
    o = jnp.einsum('bnkgqs,bnskd->bnqkgd', w, vc)
    wb = min(WINDOW, L)
    return o.reshape(bsz, L, ATT_WIDTH), k[:, L - wb:], v[:, L - wb:]


def _swa_sample(q, k, v, k_buf, v_buf, sinks):
    f32 = jnp.float32
    bsz, t = q.shape[:2]
    wb = k_buf.shape[1]
    grp = ATT_Q_HEADS // ATT_KV_HEADS
    k_all = jnp.concatenate([k_buf.astype(k.dtype), k], axis=1)
    v_all = jnp.concatenate([v_buf.astype(v.dtype), v], axis=1)
    qg = q.astype(f32).reshape(bsz, t, ATT_KV_HEADS, grp, ATT_HEAD_DIM)
    s = jnp.einsum('btkgd,bskd->bkgts', qg, k_all.astype(f32)) * (ATT_HEAD_DIM ** -0.5)
    dist = (wb + jnp.arange(t))[:, None] - jnp.arange(wb + t)[None, :]
    valid = (dist >= 0) & (dist <= WINDOW)
    slopes = _alibi_slopes(ATT_Q_HEADS).reshape(ATT_KV_HEADS, grp)[:, :, None, None]
    s = jnp.where(valid, s - slopes * dist.astype(f32), NEG_INF)
    w = _sink_softmax(s, sinks.astype(f32).reshape(ATT_KV_HEADS, grp)[:, :, None, None])
    o = jnp.einsum('bkgts,bskd->btkgd', w, v_all.astype(f32))
    return o.reshape(bsz, t, ATT_WIDTH), k_all[:, t:], v_all[:, t:]


def _layer(x, l, p, ssm_h0, ret_s0, win_kv):
    f32 = jnp.float32
    bsz, L, _ = x.shape
    proj = x @ p['w_in'][l]
    u, rq, rk, rv, rg, aq, ak, av = jnp.split(proj, _split_points(), axis=-1)
    y_ssm, h_last = _s5(u, p, l, ssm_h0)
    z = jax.nn.gelu(y_ssm)
    z = z * jax.nn.sigmoid(z @ p['ssm_glu_w'][l].astype(f32) + p['ssm_glu_b'][l].astype(f32))
    if ret_s0 is None:
        ret_s0 = jnp.zeros((bsz, RET_HEADS, RET_DK, RET_DV), f32)
    o_r, s_last = _retention(rq.reshape(bsz, L, RET_HEADS, RET_DK),
                             rk.reshape(bsz, L, RET_HEADS, RET_DK) * (RET_DK ** -0.5),
                             rv.reshape(bsz, L, RET_HEADS, RET_DV), ret_s0)
    mu = jnp.mean(o_r, -1, keepdims=True)
    var = jnp.mean(jnp.square(o_r - mu), -1, keepdims=True)
    o_r = ((o_r - mu) * lax.rsqrt(var + LN_EPS)).reshape(bsz, L, RET_WIDTH)
    o_r = o_r * p['ret_gn_g'][l].astype(f32) + p['ret_gn_b'][l].astype(f32)
    o_r = jax.nn.silu(rg.astype(f32)) * o_r
    aq = aq.reshape(bsz, L, ATT_Q_HEADS, ATT_HEAD_DIM)
    ak = ak.reshape(bsz, L, ATT_KV_HEADS, ATT_HEAD_DIM)
    av = av.reshape(bsz, L, ATT_KV_HEADS, ATT_HEAD_DIM)
    if win_kv is None:
        o_a, k_buf, v_buf = _swa_prompt(aq, ak, av, p['attn_sinks'][l])
    else:
        o_a, k_buf, v_buf = _swa_sample(aq, ak, av, win_kv[0], win_kv[1], p['attn_sinks'][l])
    mix = jnp.concatenate([z.astype(x.dtype), o_r.astype(x.dtype), o_a.astype(x.dtype)], axis=-1) @ p['w_out'][l]
    x = _layernorm(DEEPNORM_ALPHA * x + mix, p['ln1_g'][l], p['ln1_b'][l])
    hid = jax.nn.silu(x @ p['ffn_w1'][l]) * (x @ p['ffn_w3'][l])
    x = _layernorm(DEEPNORM_ALPHA * x + hid @ p['ffn_w2'][l], p['ln2_g'][l], p['ln2_b'][l])
    return x, h_last, s_last, k_buf, v_buf


def _trunk(x, p, ssm_re, ssm_im, ret_s, win_k, win_v):
    hs, ss, ks, vs = [], [], [], []
    for l in range(DEPTH):
        if ssm_re is None:
            h0, s0, kv = None, None, None
        else:
            h0 = lax.complex(ssm_re[l].astype(jnp.float32), ssm_im[l].astype(jnp.float32))
            s0 = ret_s[l].astype(jnp.float32)
            kv = (win_k[l], win_v[l])
        x, h, s, kb, vb = _layer(x, l, p, h0, s0, kv)
        hs.append(h)
        ss.append(s)
        ks.append(kb)
        vs.append(vb)
    h = jnp.stack(hs)
    return x, h.real, h.imag, jnp.stack(ss), jnp.stack(ks), jnp.stack(vs)


def setup_inputs(seed: int = 0) -> dict:
    key = jax.random.key(seed)
    keys = iter(jax.random.split(key, 32))
    f32 = jnp.float32

    def nrm(shape, scale):
        return scale * jax.random.normal(next(keys), shape, f32)

    beta = DEEPNORM_BETA
    wb = min(WINDOW, PAST_LEN)
    col_scale = jnp.concatenate([
        jnp.full((SSM_WIDTH,), beta, f32),
        jnp.ones((2 * RET_HEADS * RET_DK,), f32),
        jnp.full((RET_WIDTH,), beta, f32),
        jnp.ones((RET_WIDTH,), f32),
        jnp.ones(((ATT_Q_HEADS + ATT_KV_HEADS) * ATT_HEAD_DIM,), f32),
        jnp.full((ATT_KV_HEADS * ATT_HEAD_DIM,), beta, f32)])
    n_idx = jnp.arange(SSM_STATE, dtype=f32)
    gp = (DEPTH, SSM_GROUPS, SSM_STATE)
    x_prompt = nrm((BATCH, SEQ, D_MODEL), 1.0)
    x_sample = nrm((DEC_BATCH, DEC_SEQ, D_MODEL), 1.0)
    state_ssm_re = nrm((DEPTH, DEC_BATCH, SSM_GROUPS, SSM_STATE), 0.3)
    state_ssm_im = nrm((DEPTH, DEC_BATCH, SSM_GROUPS, SSM_STATE), 0.3)
    state_ret = nrm((DEPTH, DEC_BATCH, RET_HEADS, RET_DK, RET_DV), 1.0)
    cache_win_k = nrm((DEPTH, DEC_BATCH, wb, ATT_KV_HEADS, ATT_HEAD_DIM), 1.0)
    cache_win_v = nrm((DEPTH, DEC_BATCH, wb, ATT_KV_HEADS, ATT_HEAD_DIM), 1.0)
    w_in = nrm((DEPTH, D_MODEL, IN_WIDTH), D_MODEL ** -0.5) * col_scale
    ssm_lambda_re = -0.5 + nrm(gp, 0.01)
    ssm_lambda_im = math.pi * n_idx + nrm(gp, 0.01)
    ssm_log_step = math.log(SSM_DT_MIN) + jax.random.uniform(next(keys), (DEPTH, SSM_GROUPS), f32) * (math.log(SSM_DT_MAX) - math.log(SSM_DT_MIN))
    ssm_b_re = nrm((DEPTH, SSM_GROUPS, SSM_STATE, SSM_CH_PER_GROUP), SSM_CH_PER_GROUP ** -0.5)
    ssm_b_im = nrm((DEPTH, SSM_GROUPS, SSM_STATE, SSM_CH_PER_GROUP), SSM_CH_PER_GROUP ** -0.5)
    ssm_c_re = nrm((DEPTH, SSM_GROUPS, SSM_CH_PER_GROUP, SSM_STATE), (2 * SSM_STATE) ** -0.5)
    ssm_c_im = nrm((DEPTH, SSM_GROUPS, SSM_CH_PER_GROUP, SSM_STATE), (2 * SSM_STATE) ** -0.5)
    ssm_d = nrm((DEPTH, SSM_WIDTH), 1.0)
    ssm_glu_w = nrm((DEPTH, SSM_WIDTH, SSM_WIDTH), SSM_WIDTH ** -0.5)
    ssm_glu_b = nrm((DEPTH, SSM_WIDTH), 0.02)
    ret_gn_g = 1.0 + nrm((DEPTH, RET_WIDTH), 0.02)
    ret_gn_b = nrm((DEPTH, RET_WIDTH), 0.02)
    attn_sinks = nrm((DEPTH, ATT_Q_HEADS), 0.5)
    w_out = nrm((DEPTH, MIX_WIDTH, D_MODEL), (MIX_WIDTH ** -0.5) * beta)
    ln1_g = 1.0 + nrm((DEPTH, D_MODEL), 0.02)
    ln1_b = nrm((DEPTH, D_MODEL), 0.02)
    ffn_w1 = nrm((DEPTH, D_MODEL, FFN_HIDDEN), (D_MODEL ** -0.5) * beta)
    ffn_w3 = nrm((DEPTH, D_MODEL, FFN_HIDDEN), (D_MODEL ** -0.5) * beta)
    ffn_w2 = nrm((DEPTH, FFN_HIDDEN, D_MODEL), (FFN_HIDDEN ** -0.5) * beta)
    ln2_g = 1.0 + nrm((DEPTH, D_MODEL), 0.02)
    ln2_b = nrm((DEPTH, D_MODEL), 0.02)
    return {'x_prompt': x_prompt, 'x_sample': x_sample,
            'state_ssm_re': state_ssm_re, 'state_ssm_im': state_ssm_im, 'state_ret': state_ret,
            'cache_win_k': cache_win_k, 'cache_win_v': cache_win_v,
            'w_in': w_in, 'ssm_lambda_re': ssm_lambda_re, 'ssm_lambda_im': ssm_lambda_im,
            'ssm_log_step': ssm_log_step, 'ssm_b_re': ssm_b_re, 'ssm_b_im': ssm_b_im,
            'ssm_c_re': ssm_c_re, 'ssm_c_im': ssm_c_im, 'ssm_d': ssm_d,
            'ssm_glu_w': ssm_glu_w, 'ssm_glu_b': ssm_glu_b,
            'ret_gn_g': ret_gn_g, 'ret_gn_b': ret_gn_b, 'attn_sinks': attn_sinks,
            'w_out': w_out, 'ln1_g': ln1_g, 'ln1_b': ln1_b,
            'ffn_w1': ffn_w1, 'ffn_w3': ffn_w3, 'ffn_w2': ffn_w2,
            'ln2_g': ln2_g, 'ln2_b': ln2_b}


def reference(x_prompt, x_sample, state_ssm_re, state_ssm_im, state_ret, cache_win_k, cache_win_v,
              w_in, ssm_lambda_re, ssm_lambda_im, ssm_log_step, ssm_b_re, ssm_b_im, ssm_c_re, ssm_c_im,
              ssm_d, ssm_glu_w, ssm_glu_b, ret_gn_g, ret_gn_b, attn_sinks, w_out, ln1_g, ln1_b,
              ffn_w1, ffn_w3, ffn_w2, ln2_g, ln2_b):
    p = {'w_in': w_in, 'ssm_lambda_re': ssm_lambda_re, 'ssm_lambda_im': ssm_lambda_im,
         'ssm_log_step': ssm_log_step, 'ssm_b_re': ssm_b_re, 'ssm_b_im': ssm_b_im,
         'ssm_c_re': ssm_c_re, 'ssm_c_im': ssm_c_im, 'ssm_d': ssm_d,
         'ssm_glu_w': ssm_glu_w, 'ssm_glu_b': ssm_glu_b, 'ret_gn_g': ret_gn_g, 'ret_gn_b': ret_gn_b,
         'attn_sinks': attn_sinks, 'w_out': w_out, 'ln1_g': ln1_g, 'ln1_b': ln1_b,
         'ffn_w1': ffn_w1, 'ffn_w3': ffn_w3, 'ffn_w2': ffn_w2, 'ln2_g': ln2_g, 'ln2_b': ln2_b}
    y_prompt, p_ssm_re, p_ssm_im, p_ret, p_win_k, p_win_v = _trunk(x_prompt, p, None, None, None, None, None)
    y_sample, s_ssm_re, s_ssm_im, s_ret, s_win_k, s_win_v = _trunk(
        x_sample, p, state_ssm_re, state_ssm_im, state_ret, cache_win_k, cache_win_v)
    return (y_prompt, y_sample, p_ssm_re, p_ssm_im, p_ret, p_win_k, p_win_v,
            s_ssm_re, s_ssm_im, s_ret, s_win_k, s_win_v)
```

```cpp
#include <hip/hip_runtime.h>
#include <hip/hip_cooperative_groups.h>
#include <cstdio>
namespace cg = cooperative_groups;
namespace pg8 {
#define PG8_LAS __attribute__((address_space(3)))
typedef unsigned short bf16_t;
typedef short bf16x8 __attribute__((ext_vector_type(8)));
typedef float f32x4 __attribute__((ext_vector_type(4)));
typedef unsigned u32x4 __attribute__((ext_vector_type(4)));
constexpr int BM = 256, BK = 64, HALF = 128, HTB = HALF * BK * 2  , STAGE_BYTES = 8 * HTB, NXCD = 8, WGM = 8;

__host__ __device__ __forceinline__ int lds_byte(int r, int c) { const int st = (r >> 4) * 2 + (c >> 5), rr = r & 15, cc = c & 31, ob = rr * 64 + cc * 2; return st * 1024 + (ob ^ (((ob >> 9) & 1) << 5)); }
__host__ __device__ __forceinline__ void stage_rc(int b, int& R, int& C) { const int st = b / 1024, sb = b % 1024, swz = sb ^ (((sb >> 9) & 1) << 5); R = (st >> 1) * 16 + swz / 64; C = (st & 1) * 32 + (swz % 64) / 2; }
__host__ __device__ __forceinline__ int perm32(int rho) { const int n = rho >> 4, i = rho & 15; return 8 * (i >> 2) + 4 * n + (i & 3); }

struct Unit { int pm, pn; };
struct Gemm { const bf16_t* A; const bf16_t* Bt; int M, N, K; };

struct StaticOrder {
    int nM, nN, nwg, G, c;
    __host__ __device__ void init(int M, int N, int G_, int c_) { nM = M / BM; nN = N / BM; nwg = nM * nN; G = G_; c = c_; }
    __host__ __device__ bool next(int i, Unit& u) const {
        const long L = (long)i * G + c; if (L >= nwg) return false;
        int wgid = (int)L; { const int q = nwg / NXCD, r = nwg % NXCD, xcd = wgid % NXCD, off = wgid / NXCD; wgid = (xcd < r ? xcd * (q + 1) : r * (q + 1) + (xcd - r) * q) + off; }
        const int nig = WGM * nN, gid = wgid / nig, fm = gid * WGM, gsz = (nM - fm) < WGM ? (nM - fm) : WGM;
        u.pm = fm + ((wgid % nig) % gsz); u.pn = (wgid % nig) / gsz; return true;
    }
    __device__ __forceinline__ void a_ready(const Unit&) const {}
    __device__ __forceinline__ void done(const Unit&) const {}
};
__device__ __forceinline__ unsigned cvt_pk_bf16(float lo, float hi) { unsigned r; asm volatile("v_cvt_pk_bf16_f32 %0, %1, %2" : "=v"(r) : "v"(lo), "v"(hi)); return r; }
typedef float f32x2 __attribute__((ext_vector_type(2)));
template <class Epi, class Sched>
__device__ __forceinline__ void gemm_phase(PG8_LAS unsigned char* lds, const Gemm g, const Sched& S, const Epi& E) {
    int tid_raw = threadIdx.x; asm volatile("" : "+v"(tid_raw)); const int tid = tid_raw, wid = __builtin_amdgcn_readfirstlane(tid >> 6), lane = tid & 63, wr = wid >> 2, wc = wid & 3, fr = lane & 15, fq = lane >> 4;
    const int K = g.K, nt = K / BK;
    unsigned voffA[2], voffB[2];
#pragma unroll
    for (int i = 0; i < 2; ++i) { int R, C; stage_rc(tid * 16 + i * 8192, R, C); const int Rb = Epi::PERM ? ((R & ~31) + perm32(R & 31)) : R;
        voffA[i] = (unsigned)(R * K + C) * 2u; voffB[i] = (unsigned)(Rb * K + C) * 2u; }
    const size_t kstep = (size_t)(BK * 2);
    const size_t hstep = (size_t)HALF * K * 2;
    const size_t tstep = 2 * hstep;
    const unsigned ldsw = (unsigned)wid * 1024u;
    const int aoff = lds_byte(wr * 64 + fr, fq * 8), boff = lds_byte(wc * 32 + fr, fq * 8);
#define PG8_SA(b, h) (((b) * 2 + (h)) * HTB)
#define PG8_SB(b, h) ((4 + (b) * 2 + (h)) * HTB)
#define PG8_STAGE(bufoff, gbase, voff) do { _Pragma("unroll") for (int _i = 0; _i < 2; ++_i) \
        __builtin_amdgcn_global_load_lds((const unsigned*)((const char*)(gbase) + (voff)[_i]), (PG8_LAS unsigned*)(lds + (bufoff) + ldsw + _i * 8192), 16, 0, 0); } while (0)
#define PG8_LDA(dst, b, h) do { _Pragma("unroll") for (int m = 0; m < 4; ++m) _Pragma("unroll") for (int k = 0; k < 2; ++k) dst[m][k] = *(const PG8_LAS bf16x8*)(lds + PG8_SA(b, h) + aoff + m * 2048 + k * 1024); } while (0)
#define PG8_LDB(dst, b, h) do { _Pragma("unroll") for (int n = 0; n < 2; ++n) _Pragma("unroll") for (int k = 0; k < 2; ++k) dst[n][k] = *(const PG8_LAS bf16x8*)(lds + PG8_SB(b, h) + boff + n * 2048 + k * 1024); } while (0)
#define PG8_MMA(ai, bj, At, Bt) do { __builtin_amdgcn_s_setprio(1); _Pragma("unroll") for (int m = 0; m < 4; ++m) _Pragma("unroll") for (int n = 0; n < 2; ++n) _Pragma("unroll") for (int k = 0; k < 2; ++k) \
        acc[ai][bj][m][n] = __builtin_amdgcn_mfma_f32_16x16x32_bf16(Bt[n][k], At[m][k], acc[ai][bj][m][n], 0, 0, 0); __builtin_amdgcn_s_setprio(0); } while (0)
#define PG8_WAIT_V(n) asm volatile("s_waitcnt vmcnt(" #n ")" ::: "memory")
#define PG8_WAIT_L(n) asm volatile("s_waitcnt lgkmcnt(" #n ")" ::: "memory")
#define PG8_BAR __builtin_amdgcn_s_barrier()
#define PG8_SCHED __builtin_amdgcn_sched_barrier(0)
    Unit cur, nxt; int ui = 0;
    if (!S.next(0, cur)) return;
    f32x4 acc[2][2][4][2];
#pragma unroll
    for (int a = 0; a < 2; ++a)
#pragma unroll
        for (int b = 0; b < 2; ++b)
#pragma unroll
            for (int m = 0; m < 4; ++m)
#pragma unroll
                for (int n = 0; n < 2; ++n) acc[a][b][m][n] = (f32x4){0.f, 0.f, 0.f, 0.f};
    bf16x8 At[4][2], B0[2][2], B1[2][2];
    const char* cA = (const char*)g.A + (size_t)cur.pm * tstep; const char* cB = (const char*)g.Bt + (size_t)cur.pn * tstep;
    S.a_ready(cur);
    PG8_STAGE(PG8_SB(0, 0), cB, voffB); PG8_STAGE(PG8_SA(0, 0), cA, voffA); PG8_STAGE(PG8_SB(0, 1), cB + hstep, voffB); PG8_STAGE(PG8_SA(0, 1), cA + hstep, voffA);
    if (wr == 1) PG8_BAR;
    PG8_WAIT_V(4); PG8_BAR;
    PG8_STAGE(PG8_SB(1, 0), cB + kstep, voffB); PG8_STAGE(PG8_SA(1, 0), cA + kstep, voffA); PG8_STAGE(PG8_SB(1, 1), cB + hstep + kstep, voffB);
    PG8_WAIT_V(6); PG8_BAR;
    for (;;) {
        const bool has_next = S.next(ui + 1, nxt);
        const char* nA = has_next ? (const char*)g.A + (size_t)nxt.pm * tstep : cA; const char* nB = has_next ? (const char*)g.Bt + (size_t)nxt.pn * tstep : cB;
#pragma unroll 1
        for (int t = 0; t < nt; t += 2) {
            const bool last = (t == nt - 2);
            const char* a1 = cA + (size_t)(t + 1) * kstep;
            const char* a2 = last ? nA : cA + (size_t)(t + 2) * kstep; const char* b2 = last ? nB : cB + (size_t)(t + 2) * kstep;
            const char* a3 = a2 + kstep; const char* b3 = b2 + kstep;
            if (last && has_next) S.a_ready(nxt);
            PG8_LDB(B0, 0, 0); PG8_SCHED; PG8_LDA(At, 0, 0); PG8_STAGE(PG8_SA(1, 1), a1 + hstep, voffA);
            PG8_WAIT_L(8); PG8_BAR; PG8_WAIT_L(0); PG8_MMA(0, 0, At, B0); PG8_BAR; PG8_SCHED;
            PG8_LDB(B1, 0, 1); PG8_STAGE(PG8_SB(0, 0), b2, voffB);
            PG8_BAR; PG8_WAIT_L(0); PG8_MMA(0, 1, At, B1); PG8_BAR;
            PG8_LDA(At, 0, 1); PG8_STAGE(PG8_SA(0, 0), a2, voffA);
            PG8_BAR; PG8_WAIT_L(0); PG8_MMA(1, 0, At, B0); PG8_BAR; PG8_SCHED;
            PG8_STAGE(PG8_SB(0, 1), b2 + hstep, voffB);
            PG8_WAIT_V(6); PG8_BAR; PG8_MMA(1, 1, At, B1); PG8_BAR;
            PG8_LDB(B0, 1, 0); PG8_SCHED; PG8_LDA(At, 1, 0); PG8_STAGE(PG8_SA(0, 1), a2 + hstep, voffA);
            PG8_WAIT_L(8); PG8_BAR; PG8_WAIT_L(0); PG8_MMA(0, 0, At, B0); PG8_BAR; PG8_SCHED;
            PG8_LDB(B1, 1, 1); PG8_STAGE(PG8_SB(1, 0), b3, voffB);
            PG8_BAR; PG8_WAIT_L(0); PG8_MMA(0, 1, At, B1); PG8_BAR;
            PG8_LDA(At, 1, 1); PG8_STAGE(PG8_SA(1, 0), a3, voffA);
            PG8_BAR; PG8_WAIT_L(0); PG8_MMA(1, 0, At, B0); PG8_BAR; PG8_SCHED;
            PG8_STAGE(PG8_SB(1, 1), b3 + hstep, voffB);
            PG8_WAIT_V(6); PG8_BAR; PG8_MMA(1, 1, At, B1); PG8_BAR;
        }
        if constexpr (!Epi::AFTER_DRAIN) { E(acc, cur, wr, wc, fr, fq); S.done(cur); }
        if (!has_next) break;
#pragma unroll
        for (int a = 0; a < 2; ++a)
#pragma unroll
            for (int b = 0; b < 2; ++b)
#pragma unroll
                for (int m = 0; m < 4; ++m)
#pragma unroll
                    for (int n = 0; n < 2; ++n) acc[a][b][m][n] = (f32x4){0.f, 0.f, 0.f, 0.f};
        cur = nxt; cA = nA; cB = nB; ++ui;
    }
    PG8_WAIT_V(0);
    if (wr == 0) PG8_BAR;
    PG8_BAR;
    if constexpr (Epi::AFTER_DRAIN) { E.fused(acc, cur, wr, wc, fr, fq, lds, wid, lane); S.done(cur); }
#undef PG8_SA
#undef PG8_SB
#undef PG8_STAGE
#undef PG8_LDA
#undef PG8_LDB
#undef PG8_MMA
#undef PG8_WAIT_V
#undef PG8_WAIT_L
#undef PG8_BAR
#undef PG8_SCHED
}
}
using pg8::bf16_t; using pg8::bf16x8; using pg8::f32x4; using pg8::u32x4; using pg8::Unit;
typedef unsigned u32x2 __attribute__((ext_vector_type(2)));
#define LAS __attribute__((address_space(3)))
#define MFMA16(a, b, c) __builtin_amdgcn_mfma_f32_16x16x32_bf16((a), (b), (c), 0, 0, 0)
#define LDS_WAIT() asm volatile("s_waitcnt lgkmcnt(0)" ::: "memory")

constexpr int DM = 1024, NB = 8, SEQ = 2048, MP = NB * SEQ, MS = 128, MT = MP + MS, MPAD = 16640;
constexpr int INW = 2048, FF = 2816;
constexpr int C_U = 0, C_RQ = 384, C_RK = 640, C_RV = 896, C_RG = 1152, C_AQ = 1408, C_AK = 1792, C_AV = 1920;
constexpr float ALPHA = 1.41421356237f;
constexpr float LN_EPS = 1e-5f;
constexpr int LDS_BYTES = 147456;

constexpr size_t SZ_WIN = (size_t)2048 * 1024 * 2, SZ_WOUT = (size_t)1024 * 1024 * 2, SZ_W13 = (size_t)5632 * 1024 * 2, SZ_W2 = (size_t)1024 * 2816 * 2, SZ_GLU = (size_t)512 * 384 * 2;
constexpr size_t SZ_WL = SZ_WIN + SZ_WOUT + SZ_W13 + SZ_W2 + SZ_GLU;
constexpr size_t OFF_W = 1u << 20;
constexpr size_t SZ_BB = 24 * 8 * 16 * 16 * 2, SZ_CC = 24 * 16 * 128 * 2, SZ_LAM = 24 * 64 * 8 * 4, SZ_S5C = SZ_BB + SZ_CC + SZ_LAM;
constexpr size_t OFF_S5C = OFF_W + 2 * SZ_WL;
constexpr size_t OFF_XB = (OFF_S5C + 2 * SZ_S5C + 4095) / 4096 * 4096;
constexpr size_t SZ_XB = (size_t)MPAD * 1024 * 2;
constexpr size_t OFF_KV = OFF_XB + SZ_XB;
constexpr size_t SZ_KV = (size_t)8 * 4 * 16 * 4096 * 4;
constexpr size_t OFF_E = OFF_KV + SZ_KV;
constexpr size_t SZ_E = (size_t)8 * 32 * 24 * 128 * 4;
constexpr size_t OFF_PROJ = OFF_E + SZ_E;
constexpr size_t SZ_PROJ = (size_t)MPAD * 2048 * 2;
constexpr size_t OFF_ZPRE = OFF_PROJ + SZ_PROJ;
constexpr size_t SZ_ZPRE = (size_t)MPAD * 384 * 2;
constexpr size_t OFF_MIX = OFF_ZPRE + SZ_ZPRE;
constexpr size_t SZ_MIX = (size_t)MPAD * 1024 * 2;
constexpr size_t OFF_HID = OFF_PROJ;
constexpr size_t SZ_HID = (size_t)MPAD * FF * 2;
constexpr size_t WS_END = OFF_MIX + SZ_MIX;
static_assert(SZ_HID <= SZ_PROJ + SZ_ZPRE + SZ_MIX, "hid overlay");
static_assert(WS_END <= 268435456, "ws");

constexpr size_t O_YP = 0, O_YS = 16777216, O_PSRE = 16908288, O_PSIM = 16932864, O_PRET = 16957440, O_PWK = 17219584, O_PWV = 17481728,
                 O_SSRE = 17743872, O_SSIM = 18137088, O_SRET = 18530304, O_SWK = 22724608, O_SWV = 26918912;

__device__ __forceinline__ unsigned f2bf(float f) { unsigned u = __builtin_bit_cast(unsigned, f); return (u + 0x7fffu + ((u >> 16) & 1u)) >> 16; }
__device__ __forceinline__ unsigned pk2(float lo, float hi) { return f2bf(lo) | (f2bf(hi) << 16); }
__device__ __forceinline__ float bf2f(unsigned short b) { return __builtin_bit_cast(float, ((unsigned)b) << 16); }
__device__ __forceinline__ float bflo(unsigned w) { return __builtin_bit_cast(float, w << 16); }
__device__ __forceinline__ float bfhi(unsigned w) { return __builtin_bit_cast(float, w & 0xffff0000u); }
__device__ __forceinline__ float sigmoidf_(float x) { return __builtin_amdgcn_rcpf(1.0f + __expf(-x)); }
__device__ __forceinline__ float siluf_(float x) { return x * sigmoidf_(x); }
__device__ __forceinline__ float gelu_tanh(float x) { const float u = 0.7978845608f * (x + 0.044715f * x * x * x); const float t = 1.0f - 2.0f / (__expf(2.0f * u) + 1.0f); return 0.5f * x * (1.0f + t); }
__device__ __forceinline__ float wave_sum(float v) {
#pragma unroll
    for (int o = 1; o < 64; o <<= 1) v += __shfl_xor(v, o);
    return v;
}

struct Params { const float* in[29]; float* out; unsigned char* ws; };

struct EpiProj {
    static constexpr bool PERM = true, AFTER_DRAIN = false;
    bf16_t* O; float* wk; float* wv;
    __device__ __forceinline__ void operator()(const f32x4 (&acc)[2][2][4][2], const Unit& u, int wr, int wc, int fr, int fq) const {
        const int row0 = u.pm * 256 + wr * 64 + fr, col0 = u.pn * 256 + wc * 32 + 8 * fq;
#pragma unroll
        for (int ai = 0; ai < 2; ++ai)
#pragma unroll
            for (int m = 0; m < 4; ++m) { bf16_t* rowp = O + (size_t)(row0 + ai * 128 + m * 16) * INW + col0;
#pragma unroll
                for (int bj = 0; bj < 2; ++bj) { const f32x4 v0 = acc[ai][bj][m][0], v1 = acc[ai][bj][m][1];
                    u32x4 w; w.x = pk2(v0[0], v0[1]); w.y = pk2(v0[2], v0[3]); w.z = pk2(v1[0], v1[1]); w.w = pk2(v1[2], v1[3]);
                    *(u32x4*)(rowp + bj * 128) = w; } }
        if (u.pn == 7 && u.pm < 64 && (u.pm & 7) == 7) {
            const int b = u.pm >> 3, cw = wc * 32 + 8 * fq;
#pragma unroll
            for (int m = 0; m < 4; ++m) { const int t = wr * 64 + m * 16 + fr; const size_t o = (size_t)(b * 128 + t) * 128 + cw;
#pragma unroll
                for (int n = 0; n < 2; ++n) { *(f32x4*)(wk + o + 4 * n) = acc[1][0][m][n]; *(f32x4*)(wv + o + 4 * n) = acc[1][1][m][n]; } }
        }
    }
};
struct EpiGlu {
    static constexpr bool PERM = true, AFTER_DRAIN = false;
    const bf16_t* Z; bf16_t* O; const float* bias;
    __device__ __forceinline__ void operator()(const f32x4 (&acc)[2][2][4][2], const Unit& u, int wr, int wc, int fr, int fq) const {
        const int row0 = u.pm * 256 + wr * 64 + fr, col0 = u.pn * 256 + wc * 32 + 8 * fq;
#pragma unroll
        for (int bj = 0; bj < 2; ++bj) { const int c = col0 + bj * 128; if (c >= 384) continue;
#pragma unroll
            for (int n = 0; n < 2; ++n) { const f32x4 b0 = *(const f32x4*)(bias + c + 4 * n);
#pragma unroll
                for (int ai = 0; ai < 2; ++ai)
#pragma unroll
                    for (int m = 0; m < 4; ++m) { const size_t row = (size_t)(row0 + ai * 128 + m * 16);
                        const u32x2 z = *(const u32x2*)(Z + row * 384 + c + 4 * n); const f32x4 v0 = acc[ai][bj][m][n] + b0;
                        u32x2 w;
                        w.x = pk2(bflo(z.x) * sigmoidf_(v0[0]), bfhi(z.x) * sigmoidf_(v0[1])); w.y = pk2(bflo(z.y) * sigmoidf_(v0[2]), bfhi(z.y) * sigmoidf_(v0[3]));
                        *(u32x2*)(O + row * 1024 + c + 4 * n) = w; asm volatile("" ::: "memory"); } } }
    }
};
struct EpiResid {
    static constexpr bool PERM = false, AFTER_DRAIN = false;
    const float* xp; const float* xs; float* xres;
    __device__ __forceinline__ void operator()(const f32x4 (&acc)[2][2][4][2], const Unit& u, int wr, int wc, int fr, int fq) const {
        const int row0 = u.pm * 256 + wr * 64 + fr, col0 = u.pn * 256 + wc * 32 + 4 * fq;
#pragma unroll
        for (int ai = 0; ai < 2; ++ai)
#pragma unroll
            for (int m = 0; m < 4; ++m) { const int row = row0 + ai * 128 + m * 16; if (row >= MT) continue;
                const float* bp = xs ? (row < MP ? xp + (size_t)row * 1024 : xs + (size_t)(row - MP) * 1024) : xres + (size_t)row * 1024; float* op = xres + (size_t)row * 1024;
#pragma unroll
                for (int bj = 0; bj < 2; ++bj)
#pragma unroll
                    for (int n = 0; n < 2; ++n) { const int c = col0 + bj * 128 + n * 16; const f32x4 bs = *(const f32x4*)(bp + c); *(f32x4*)(op + c) = bs * ALPHA + acc[ai][bj][m][n]; } }
    }
};
struct EpiSwiglu {
    static constexpr bool PERM = true, AFTER_DRAIN = false;
    bf16_t* H;
    __device__ __forceinline__ void operator()(const f32x4 (&acc)[2][2][4][2], const Unit& u, int wr, int wc, int fr, int fq) const {
        const int row0 = u.pm * 256 + wr * 64 + fr, col0 = u.pn * 128 + wc * 32 + 8 * fq;
#pragma unroll
        for (int ai = 0; ai < 2; ++ai)
#pragma unroll
            for (int m = 0; m < 4; ++m) { const size_t row = (size_t)(row0 + ai * 128 + m * 16);
                const f32x4 a0 = acc[ai][0][m][0], a1 = acc[ai][0][m][1], g0 = acc[ai][1][m][0], g1 = acc[ai][1][m][1];
                u32x4 w; w.x = pk2(siluf_(a0[0]) * g0[0], siluf_(a0[1]) * g0[1]); w.y = pk2(siluf_(a0[2]) * g0[2], siluf_(a0[3]) * g0[3]);
                w.z = pk2(siluf_(a1[0]) * g1[0], siluf_(a1[1]) * g1[1]); w.w = pk2(siluf_(a1[2]) * g1[2], siluf_(a1[3]) * g1[3]);
                *(u32x4*)(H + row * FF + col0) = w; }
    }
};
__device__ __forceinline__ void transpose_item(const float* W, int K, int N, bf16_t* WT, int mode, LAS float* scr, int item, int lane) {
    const int nblk = N / 32, kb = item / nblk, nb = item % nblk, k0 = 64 * kb, n0 = 32 * nb;
#pragma unroll 8
    for (int i = 0; i < 32; ++i) { const int kk = 2 * i + (lane >> 5); scr[kk * 33 + (lane & 31)] = W[(size_t)(k0 + kk) * N + n0 + (lane & 31)]; }
    LDS_WAIT();
    const int c = lane & 7;
#pragma unroll
    for (int j = 0; j < 4; ++j) { const int n = (lane >> 3) + 8 * j; const LAS float* s = scr + (8 * c) * 33 + n;
        u32x4 o; o.x = pk2(s[0 * 33], s[1 * 33]); o.y = pk2(s[2 * 33], s[3 * 33]); o.z = pk2(s[4 * 33], s[5 * 33]); o.w = pk2(s[6 * 33], s[7 * 33]);
        const int nn = n0 + n; const int row = mode == 0 ? nn : ((nn >> 7) * 256 + (mode == 2 ? 128 : 0) + (nn & 127));
        *(u32x4*)(WT + (size_t)row * K + k0 + 8 * c) = o; }
    LDS_WAIT();
}
__device__ __forceinline__ void sincos_d(double x, double& s, double& c) {
    const double TWO_PI = 6.283185307179586476925287; x -= TWO_PI * rint(x / TWO_PI);
    const double y = x * 0.125, y2 = y * y;
    double sn = y * (1.0 + y2 * (-1.0 / 6 + y2 * (1.0 / 120 + y2 * (-1.0 / 5040 + y2 * (1.0 / 362880 + y2 * (-1.0 / 39916800 + y2 * (1.0 / 6227020800.0)))))));
    double cs = 1.0 + y2 * (-0.5 + y2 * (1.0 / 24 + y2 * (-1.0 / 720 + y2 * (1.0 / 40320 + y2 * (-1.0 / 3628800 + y2 * (1.0 / 479001600.0))))));
#pragma unroll
    for (int i = 0; i < 3; ++i) { const double s2 = 2.0 * sn * cs, c2 = 1.0 - 2.0 * sn * sn; sn = s2; cs = c2; }
    s = sn; c = cs;
}
__device__ __forceinline__ void phase0(const Params& P, LAS unsigned char* lds, int gw, int NGW, int wave, int lane) {
    unsigned char* ws = P.ws;
    LAS float* scr = (LAS float*)(lds + wave * 16384);
    constexpr int I_IN = 16 * 64, I_OUT = 16 * 32, I_W1 = 16 * 88, I_W2 = 44 * 32, I_GL = 6 * 12, I_L = I_IN + I_OUT + 2 * I_W1 + I_W2 + I_GL;
    for (int it = gw; it < 2 * I_L; it += NGW) {
        const int l = it / I_L; int r = it % I_L; unsigned char* wl = ws + OFF_W + (size_t)l * SZ_WL;
        if (r < I_IN) { transpose_item(P.in[7] + (size_t)l * 1024 * 2048, 1024, 2048, (bf16_t*)wl, 0, scr, r, lane); continue; } r -= I_IN;
        if (r < I_OUT) { transpose_item(P.in[21] + (size_t)l * 1024 * 1024, 1024, 1024, (bf16_t*)(wl + SZ_WIN), 0, scr, r, lane); continue; } r -= I_OUT;
        if (r < I_W1) { transpose_item(P.in[24] + (size_t)l * 1024 * FF, 1024, FF, (bf16_t*)(wl + SZ_WIN + SZ_WOUT), 1, scr, r, lane); continue; } r -= I_W1;
        if (r < I_W1) { transpose_item(P.in[25] + (size_t)l * 1024 * FF, 1024, FF, (bf16_t*)(wl + SZ_WIN + SZ_WOUT), 2, scr, r, lane); continue; } r -= I_W1;
        if (r < I_W2) { transpose_item(P.in[26] + (size_t)l * FF * 1024, FF, 1024, (bf16_t*)(wl + SZ_WIN + SZ_WOUT + SZ_W13), 0, scr, r, lane); continue; } r -= I_W2;
        transpose_item(P.in[16] + (size_t)l * 384 * 384, 384, 384, (bf16_t*)(wl + SZ_WIN + SZ_WOUT + SZ_W13 + SZ_W2), 0, scr, r, lane);
    }
    const int gt = gw * 64 + lane, NGT = NGW * 64;
    for (int i = gt; i < 2 * 6144; i += NGT) { const int l = i / 6144, j = i % 6144;
        *(u32x4*)(ws + OFF_W + (size_t)l * SZ_WL + SZ_WIN + SZ_WOUT + SZ_W13 + SZ_W2 + (size_t)384 * 384 * 2 + (size_t)j * 16) = (u32x4){0u, 0u, 0u, 0u}; }
    { bf16_t* xb = (bf16_t*)(ws + OFF_XB);
      for (int i = gt; i < MT * 128; i += NGT) { const size_t e = (size_t)i * 8; const float* src = e < (size_t)MP * 1024 ? P.in[0] + e : P.in[1] + (e - (size_t)MP * 1024);
          const f32x4 a = *(const f32x4*)src, b = *(const f32x4*)(src + 4); u32x4 w; w.x = pk2(a[0], a[1]); w.y = pk2(a[2], a[3]); w.z = pk2(b[0], b[1]); w.w = pk2(b[2], b[3]);
          *(u32x4*)(xb + e) = w; } }
    for (int i = gt; i < 2 * 24 * 64; i += NGT) {
        const int l = i / 1536, g = (i % 1536) / 64, p = i % 64; const int gi = l * 24 + g;
        bf16_t* Bb = (bf16_t*)(ws + OFF_S5C + (size_t)l * SZ_S5C); bf16_t* Cc = (bf16_t*)(ws + OFF_S5C + (size_t)l * SZ_S5C + SZ_BB); float* lam = (float*)(ws + OFF_S5C + (size_t)l * SZ_S5C + SZ_BB + SZ_CC);
        const double a = (double)P.in[8][gi * 64 + p], w = (double)P.in[9][gi * 64 + p], step = exp((double)P.in[10][gi]);
        double s1, c1, s16, c16, s64, c64; sincos_d(w * step, s1, c1); sincos_d(16.0 * w * step, s16, c16); sincos_d(64.0 * w * step, s64, c64);
        const double m1 = exp(a * step), m16 = exp(16.0 * a * step), m64 = exp(64.0 * a * step);
        float* lp = lam + (g * 64 + p) * 8;
        lp[0] = (float)(m1 * c1); lp[1] = (float)(m1 * s1); lp[2] = (float)(m16 * c16); lp[3] = (float)(m16 * s16); lp[4] = (float)(m64 * c64); lp[5] = (float)(m64 * s64); lp[6] = 0.f; lp[7] = 0.f;
        const double nr = m1 * c1 - 1.0, ni = m1 * s1, den = a * a + w * w; const double fr_ = (nr * a + ni * w) / den, fi_ = (ni * a - nr * w) / den;
        const int j = p >> 4, n = p & 15;
        for (int h = 0; h < 16; ++h) { const double br = (double)P.in[11][(size_t)(gi * 64 + p) * 16 + h], bi = (double)P.in[12][(size_t)(gi * 64 + p) * 16 + h];
            Bb[((g * 8 + 2 * j) * 16 + n) * 16 + h] = (bf16_t)f2bf((float)(fr_ * br - fi_ * bi)); Bb[((g * 8 + 2 * j + 1) * 16 + n) * 16 + h] = (bf16_t)f2bf((float)(fr_ * bi + fi_ * br));
            Cc[(g * 16 + h) * 128 + 2 * p] = (bf16_t)f2bf(P.in[13][(size_t)(gi * 16 + h) * 64 + p]); Cc[(g * 16 + h) * 128 + 2 * p + 1] = (bf16_t)f2bf(-P.in[14][(size_t)(gi * 16 + h) * 64 + p]); }
    }
}
__device__ __forceinline__ void ln_phase(float* xres, bf16_t* xb, const float* g, const float* b, int gw, int NGW, int lane) {
    f32x4 gv[4], bv[4];
#pragma unroll
    for (int j = 0; j < 4; ++j) { gv[j] = ((const f32x4*)g)[lane + 64 * j]; bv[j] = ((const f32x4*)b)[lane + 64 * j]; }
    for (int row = gw; row < MT; row += NGW) {
        f32x4* xr = (f32x4*)(xres + (size_t)row * 1024) + lane; f32x4 v[4]; float s = 0.f;
#pragma unroll
        for (int j = 0; j < 4; ++j) { v[j] = xr[64 * j]; s += (v[j][0] + v[j][1]) + (v[j][2] + v[j][3]); }
        const float mean = wave_sum(s) * (1.f / 1024.f); float s2 = 0.f;
#pragma unroll
        for (int j = 0; j < 4; ++j) { v[j] = v[j] - mean; s2 += (v[j][0] * v[j][0] + v[j][1] * v[j][1]) + (v[j][2] * v[j][2] + v[j][3] * v[j][3]); }
        const float rstd = 1.f / sqrtf(wave_sum(s2) * (1.f / 1024.f) + LN_EPS);
        u32x2* o8 = (u32x2*)(xb + (size_t)row * 1024) + lane;
#pragma unroll
        for (int j = 0; j < 4; ++j) { const f32x4 o = v[j] * rstd * gv[j] + bv[j]; xr[64 * j] = o; u32x2 w; w.x = pk2(o[0], o[1]); w.y = pk2(o[2], o[3]); o8[64 * j] = w; }
    }
}
constexpr int HS_STRIDE = 272;
template <int PASS>
__device__ __forceinline__ void s5_tile(const bf16_t* proj, const bf16_t* Bb, const bf16_t* Cc, const float* lam, const float* Dv, float* E, bf16_t* zpre,
                                        float* ore, float* oim  , int b, int g, int tile, LAS unsigned char* wl, int lane) {
    const int fr = lane & 15, q4 = lane >> 4;
    const size_t tok0 = (size_t)b * SEQ + (size_t)tile * 64;
    const bf16x8 zero8 = (bf16x8){0, 0, 0, 0, 0, 0, 0, 0};
    bf16x8 af[4];
#pragma unroll
    for (int mt = 0; mt < 4; ++mt) { const int tau = 16 * (fr >> 2) + 4 * mt + (fr & 3);
        af[mt] = q4 < 2 ? *(const bf16x8*)(proj + (tok0 + tau) * INW + C_U + g * 16 + 8 * q4) : zero8; }
#pragma unroll 1
    for (int jh = 0; jh < 2; ++jh) {
        f32x4 acc[4][4];
#pragma unroll
        for (int nt = 0; nt < 4; ++nt) { const bf16x8 bfr = q4 < 2 ? *(const bf16x8*)(Bb + ((g * 8 + 4 * jh + nt) * 16 + fr) * 16 + 8 * q4) : zero8;
#pragma unroll
            for (int mt = 0; mt < 4; ++mt) acc[nt][mt] = MFMA16(af[mt], bfr, ((f32x4){0.f, 0.f, 0.f, 0.f})); }
        float lre[2], lim[2], l16r[2], l16i[2], l64r[2], l64i[2];
#pragma unroll
        for (int j = 0; j < 2; ++j) { const float* lp = lam + (g * 64 + 16 * (2 * jh + j) + fr) * 8; const f32x4 a = *(const f32x4*)lp; const f32x4 c = *(const f32x4*)(lp + 4);
            lre[j] = a[0]; lim[j] = a[1]; l16r[j] = a[2]; l16i[j] = a[3]; l64r[j] = c[0]; l64i[j] = c[1]; }
#pragma unroll
        for (int j = 0; j < 2; ++j) { float hr = 0.f, hi = 0.f;
#pragma unroll
            for (int mt = 0; mt < 4; ++mt)
#pragma unroll
                for (int r = 0; r < 4; ++r) { const float nr = lre[j] * hr - lim[j] * hi + acc[2 * j][mt][r], ni = lre[j] * hi + lim[j] * hr + acc[2 * j + 1][mt][r];
                    acc[2 * j][mt][r] = nr; acc[2 * j + 1][mt][r] = ni; hr = nr; hi = ni; } }
        float c0r[2] = {0.f, 0.f}, c0i[2] = {0.f, 0.f};
        if (PASS == 2) {
            const float* Eb = E + ((size_t)(b * 32) * 24 + g) * 128 + fr * 8 + 4 * jh;
            for (int k0 = 0; k0 < tile; k0 += 8) {
                f32x4 ev[8];
#pragma unroll
                for (int kk = 0; kk < 8; ++kk) { const int k = (k0 + kk < tile) ? k0 + kk : 0; ev[kk] = *(const f32x4*)(Eb + (size_t)k * 3072); }
#pragma unroll
                for (int kk = 0; kk < 8; ++kk) if (k0 + kk < tile) {
#pragma unroll
                    for (int j = 0; j < 2; ++j) { const float er = ev[kk][2 * j], ei = ev[kk][2 * j + 1];
                        const float nr = l64r[j] * c0r[j] - l64i[j] * c0i[j] + er, ni = l64r[j] * c0i[j] + l64i[j] * c0r[j] + ei; c0r[j] = nr; c0i[j] = ni; } }
            }
        }
        float cr[2], ci[2], endr[2], endi[2];
#pragma unroll
        for (int j = 0; j < 2; ++j) {
            const float er = acc[2 * j][3][3], ei = acc[2 * j + 1][3][3];
            float xr = c0r[j], xi = c0i[j]; cr[j] = xr; ci[j] = xi;
#pragma unroll
            for (int q = 0; q < 4; ++q) { const float eqr = __shfl(er, fr + 16 * q), eqi = __shfl(ei, fr + 16 * q);
                const float nr = l16r[j] * xr - l16i[j] * xi + eqr, ni = l16r[j] * xi + l16i[j] * xr + eqi; xr = nr; xi = ni;
                if (q + 1 < 4 && q4 == q + 1) { cr[j] = xr; ci[j] = xi; } }
            endr[j] = xr; endi[j] = xi;
        }
        if (PASS == 1) {
            if (q4 == 0) { float* Ep = E + ((size_t)(b * 32 + tile) * 24 + g) * 128 + fr * 8 + 4 * jh; *(f32x4*)Ep = (f32x4){endr[0], endi[0], endr[1], endi[1]}; }
        } else {
            if (tile == 31 && q4 == 0) {
#pragma unroll
                for (int j = 0; j < 2; ++j) { ore[(size_t)(b * 24 + g) * 64 + 16 * (2 * jh + j) + fr] = endr[j]; oim[(size_t)(b * 24 + g) * 64 + 16 * (2 * jh + j) + fr] = endi[j]; } }
#pragma unroll
            for (int j = 0; j < 2; ++j) { float wr_ = cr[j], wi_ = ci[j];
#pragma unroll
                for (int mt = 0; mt < 4; ++mt)
#pragma unroll
                    for (int r = 0; r < 4; ++r) { const float nr = lre[j] * wr_ - lim[j] * wi_, ni = lre[j] * wi_ + lim[j] * wr_; wr_ = nr; wi_ = ni;
                        const int tau = 16 * q4 + 4 * mt + r;
                        *(LAS unsigned*)(wl + tau * HS_STRIDE + (16 * (2 * jh + j) + fr) * 4) = pk2(acc[2 * j][mt][r] + wr_, acc[2 * j + 1][mt][r] + wi_); } }
        }
    }
    if (PASS == 1) return;
    LDS_WAIT();
    f32x4 y[4];
#pragma unroll
    for (int mt = 0; mt < 4; ++mt) y[mt] = (f32x4){0.f, 0.f, 0.f, 0.f};
#pragma unroll
    for (int ks = 0; ks < 4; ++ks) { const bf16x8 bfr = *(const bf16x8*)(Cc + (g * 16 + fr) * 128 + 32 * ks + 8 * q4);
#pragma unroll
        for (int mt = 0; mt < 4; ++mt) { const bf16x8 afr = *(const LAS bf16x8*)(wl + (16 * mt + fr) * HS_STRIDE + (32 * ks + 8 * q4) * 2); y[mt] = MFMA16(afr, bfr, y[mt]); } }
    LDS_WAIT();
    const float dv = Dv[g * 16 + fr];
#pragma unroll
    for (int mt = 0; mt < 4; ++mt)
#pragma unroll
        for (int r = 0; r < 4; ++r) { const size_t tok = tok0 + 16 * mt + 4 * q4 + r; const float uv = bf2f(proj[tok * INW + C_U + g * 16 + fr]);
            zpre[tok * 384 + g * 16 + fr] = (bf16_t)f2bf(gelu_tanh(y[mt][r] + dv * uv)); }
}
__device__ __forceinline__ float ret_log2g(int h) { return log2f(1.0f - exp2f(-5.0f - (float)h)); }
__device__ __forceinline__ void ret_kv_task(const bf16_t* proj, float* KV, int b, int h, int c, int lane) {
    const int fr = lane & 15, q4 = lane >> 4; const size_t tok0 = (size_t)b * SEQ + (size_t)c * 128; const float l2g = ret_log2g(h);
    f32x4 acc[4][4];
#pragma unroll
    for (int dt = 0; dt < 4; ++dt)
#pragma unroll
        for (int et = 0; et < 4; ++et) acc[dt][et] = (f32x4){0.f, 0.f, 0.f, 0.f};
    for (int ks = 0; ks < 4; ++ks) {
        const int j0 = 32 * ks + 8 * q4; float dec[8];
#pragma unroll
        for (int i = 0; i < 8; ++i) dec[i] = 0.125f * exp2f(l2g * (float)(127 - j0 - i));
        bf16x8 af[4], bfv[4];
#pragma unroll
        for (int t = 0; t < 4; ++t) {
#pragma unroll
            for (int i = 0; i < 8; ++i) { const bf16_t* rp = proj + (tok0 + j0 + i) * INW + h * 64 + 16 * t + fr;
                af[t][i] = (short)f2bf(bf2f(rp[C_RK]) * dec[i]); bfv[t][i] = (short)rp[C_RV]; } }
#pragma unroll
        for (int dt = 0; dt < 4; ++dt)
#pragma unroll
            for (int et = 0; et < 4; ++et) acc[dt][et] = MFMA16(af[dt], bfv[et], acc[dt][et]);
    }
    float* o = KV + ((size_t)((b * 4 + h) * 16 + c)) * 4096;
#pragma unroll
    for (int dt = 0; dt < 4; ++dt)
#pragma unroll
        for (int et = 0; et < 4; ++et)
#pragma unroll
            for (int r = 0; r < 4; ++r) o[(16 * dt + 4 * q4 + r) * 64 + 16 * et + fr] = acc[dt][et][r];
}
constexpr int VT_STRIDE = 272, ST_STRIDE = 144;
__device__ __forceinline__ void ret_out_task(const bf16_t* proj, const float* KV, bf16_t* mix, const float* gng, const float* gnb, float* pret  ,
                                             int b, int h, int c, LAS unsigned char* lds, int tid) {
    const int lane = tid & 63, wave = tid >> 6, fr = lane & 15, q4 = lane >> 4; const size_t tok0 = (size_t)b * SEQ + (size_t)c * 128;
    const float l2g = ret_log2g(h); const float cd = exp2f(l2g * 128.f);
    LAS unsigned char* Vt = lds; LAS unsigned char* St = lds + 64 * VT_STRIDE;
    { const float* kvb = KV + ((size_t)(b * 4 + h) * 16) * 4096; float s[8];
#pragma unroll
      for (int i = 0; i < 8; ++i) s[i] = 0.f;
      for (int cc = 0; cc < c; ++cc) {
#pragma unroll
          for (int i = 0; i < 8; ++i) s[i] = cd * s[i] + kvb[(size_t)cc * 4096 + tid + 512 * i]; }
#pragma unroll
      for (int i = 0; i < 8; ++i) { const int idx = tid + 512 * i, d = idx >> 6, e = idx & 63; *(LAS unsigned short*)(St + e * ST_STRIDE + d * 2) = (unsigned short)f2bf(s[i]); }
      if (c == 15) {
#pragma unroll
          for (int i = 0; i < 8; ++i) pret[(size_t)(b * 4 + h) * 4096 + tid + 512 * i] = cd * s[i] + kvb[(size_t)15 * 4096 + tid + 512 * i]; } }
#pragma unroll
    for (int i = 0; i < 2; ++i) { const int idx = tid + 512 * i, j = idx >> 3, e0 = (idx & 7) * 8; const u32x4 v = *(const u32x4*)(proj + (tok0 + j) * INW + C_RV + h * 64 + e0);
        const unsigned w[4] = {v.x, v.y, v.z, v.w};
#pragma unroll
        for (int k = 0; k < 4; ++k) { *(LAS unsigned short*)(Vt + (e0 + 2 * k) * VT_STRIDE + j * 2) = (unsigned short)(w[k] & 0xffffu); *(LAS unsigned short*)(Vt + (e0 + 2 * k + 1) * VT_STRIDE + j * 2) = (unsigned short)(w[k] >> 16); } }
    __syncthreads();
    const int it = wave;
    const size_t qtok = tok0 + 16 * it + fr;
    bf16x8 qf[2];
#pragma unroll
    for (int ks = 0; ks < 2; ++ks) qf[ks] = *(const bf16x8*)(proj + qtok * INW + C_RQ + h * 64 + 32 * ks + 8 * q4);
    f32x4 o1[4], o2[4];
#pragma unroll
    for (int et = 0; et < 4; ++et) { o1[et] = (f32x4){0.f, 0.f, 0.f, 0.f}; o2[et] = (f32x4){0.f, 0.f, 0.f, 0.f};
#pragma unroll
        for (int ks = 0; ks < 2; ++ks) { const bf16x8 a = *(const LAS bf16x8*)(St + (16 * et + fr) * ST_STRIDE + (32 * ks + 8 * q4) * 2); o2[et] = MFMA16(a, qf[ks], o2[et]); } }
    const int iq = 16 * it + fr;
    for (int jp = 0; jp <= (it >> 1); ++jp) {
        f32x4 sc[2];
#pragma unroll
        for (int tt = 0; tt < 2; ++tt) { const int jt = 2 * jp + tt; sc[tt] = (f32x4){0.f, 0.f, 0.f, 0.f};
            if (jt <= it) {
#pragma unroll
                for (int ks = 0; ks < 2; ++ks) { const bf16x8 kf = *(const bf16x8*)(proj + (tok0 + 16 * jt + fr) * INW + C_RK + h * 64 + 32 * ks + 8 * q4); sc[tt] = MFMA16(kf, qf[ks], sc[tt]); }
#pragma unroll
                for (int r = 0; r < 4; ++r) { const int diff = iq - (16 * jt + 4 * q4 + r); sc[tt][r] = diff >= 0 ? sc[tt][r] * 0.125f * exp2f(l2g * (float)diff) : 0.f; } } }
        bf16x8 pb; { const unsigned w0 = pk2(sc[0][0], sc[0][1]), w1 = pk2(sc[0][2], sc[0][3]), w2 = pk2(sc[1][0], sc[1][1]), w3 = pk2(sc[1][2], sc[1][3]);
            const u32x4 pw = (u32x4){w0, w1, w2, w3}; pb = __builtin_bit_cast(bf16x8, pw); }
#pragma unroll
        for (int et = 0; et < 4; ++et) { const LAS unsigned char* vp = Vt + (16 * et + fr) * VT_STRIDE + (32 * jp + 4 * q4) * 2;
            const u32x2 a0 = *(const LAS u32x2*)vp, a1 = *(const LAS u32x2*)(vp + 32); const u32x4 aw = (u32x4){a0.x, a0.y, a1.x, a1.y};
            o1[et] = MFMA16(__builtin_bit_cast(bf16x8, aw), pb, o1[et]); }
    }
    const float idec = exp2f(l2g * (float)(iq + 1)); float v[4][4]; float s = 0.f;
#pragma unroll
    for (int et = 0; et < 4; ++et)
#pragma unroll
        for (int r = 0; r < 4; ++r) { v[et][r] = o1[et][r] + o2[et][r] * idec; s += v[et][r]; }
    s += __shfl_xor(s, 16); s += __shfl_xor(s, 32); const float mean = s * (1.f / 64.f); float s2 = 0.f;
#pragma unroll
    for (int et = 0; et < 4; ++et)
#pragma unroll
        for (int r = 0; r < 4; ++r) { v[et][r] -= mean; s2 += v[et][r] * v[et][r]; }
    s2 += __shfl_xor(s2, 16); s2 += __shfl_xor(s2, 32); const float rstd = 1.f / sqrtf(s2 * (1.f / 64.f) + LN_EPS);
#pragma unroll
    for (int et = 0; et < 4; ++et) { const int e = h * 64 + 16 * et + 4 * q4; const f32x4 gg = *(const f32x4*)(gng + e), bb = *(const f32x4*)(gnb + e);
        const u32x2 rgw = *(const u32x2*)(proj + qtok * INW + C_RG + e);
        const float g0 = bflo(rgw.x), g1 = bfhi(rgw.x), g2 = bflo(rgw.y), g3 = bfhi(rgw.y);
        u32x2 w; w.x = pk2(siluf_(g0) * (v[et][0] * rstd * gg[0] + bb[0]), siluf_(g1) * (v[et][1] * rstd * gg[1] + bb[1]));
        w.y = pk2(siluf_(g2) * (v[et][2] * rstd * gg[2] + bb[2]), siluf_(g3) * (v[et][3] * rstd * gg[3] + bb[3]));
        *(u32x2*)(mix + qtok * 1024 + 384 + e) = w; }
    __syncthreads();
}
constexpr int AVT_STRIDE = 544;
__device__ __forceinline__ float alibi_slope(int hq) { return hq == 0 ? 0.25f : hq == 1 ? 0.0625f : hq == 2 ? 0.015625f : hq == 3 ? 0.00390625f : hq == 4 ? 0.5f : 0.125f; }
__device__ __forceinline__ void swa_task(const bf16_t* proj, bf16_t* mix, const float* sinks, int b, int nb, int kvh, LAS unsigned char* lds, int tid) {
    const int lane = tid & 63, wave = tid >> 6, fr = lane & 15, q4 = lane >> 4;
    const long ftok0 = (long)b * SEQ + (long)(nb - 1) * 128;
    LAS unsigned char* Vt = lds;
#pragma unroll
    for (int i = 0; i < 4; ++i) { const int idx = tid + 512 * i, key = idx >> 3, d0 = (idx & 7) * 8; u32x4 v = (u32x4){0u, 0u, 0u, 0u};
        if (nb > 0 || key >= 128) v = *(const u32x4*)(proj + (size_t)(ftok0 + key) * INW + C_AV + kvh * 64 + d0);
        const unsigned w[4] = {v.x, v.y, v.z, v.w};
#pragma unroll
        for (int k = 0; k < 4; ++k) { *(LAS unsigned short*)(Vt + (d0 + 2 * k) * AVT_STRIDE + key * 2) = (unsigned short)(w[k] & 0xffffu); *(LAS unsigned short*)(Vt + (d0 + 2 * k + 1) * AVT_STRIDE + key * 2) = (unsigned short)(w[k] >> 16); } }
    __syncthreads();
    const int qt = wave; const size_t qtok = (size_t)(ftok0 + 128 + 16 * qt + fr);
#pragma unroll 1
    for (int g3 = 0; g3 < 3; ++g3) {
        const int hq = kvh * 3 + g3; const float slope = alibi_slope(hq), sink = sinks[hq];
        bf16x8 qf[2];
#pragma unroll
        for (int ks = 0; ks < 2; ++ks) qf[ks] = *(const bf16x8*)(proj + qtok * INW + C_AQ + hq * 64 + 32 * ks + 8 * q4);
        f32x4 s[10]; float mx = sink;
#pragma unroll
        for (int kt = 0; kt < 9; ++kt) { const int T = qt + kt; s[kt] = (f32x4){0.f, 0.f, 0.f, 0.f};
            const bool live = (nb > 0 || T >= 8);
            if (live) {
#pragma unroll
                for (int ks = 0; ks < 2; ++ks) { const bf16x8 kf = *(const bf16x8*)(proj + (size_t)(ftok0 + 16 * T + fr) * INW + C_AK + kvh * 64 + 32 * ks + 8 * q4); s[kt] = MFMA16(kf, qf[ks], s[kt]); } }
#pragma unroll
            for (int r = 0; r < 4; ++r) { const int dist = 128 - 16 * kt + fr - 4 * q4 - r; const bool ok = live && dist >= 0 && dist <= 128;
                const float v = ok ? s[kt][r] * 0.125f - slope * (float)dist : -1e30f; s[kt][r] = v; mx = fmaxf(mx, v); }
            if (kt % 3 == 2) asm volatile("" ::: "memory"); }
        s[9] = (f32x4){-1e30f, -1e30f, -1e30f, -1e30f};
        mx = fmaxf(mx, __shfl_xor(mx, 16)); mx = fmaxf(mx, __shfl_xor(mx, 32));
        float den = 0.f;
#pragma unroll
        for (int kt = 0; kt < 10; ++kt)
#pragma unroll
            for (int r = 0; r < 4; ++r) { const float e = s[kt][r] > -1e29f ? __expf(s[kt][r] - mx) : 0.f; s[kt][r] = e; den += e; }
        den += __shfl_xor(den, 16); den += __shfl_xor(den, 32); den += __expf(sink - mx);
        const float inv = 1.f / den;
        f32x4 o[4];
#pragma unroll
        for (int dt = 0; dt < 4; ++dt) o[dt] = (f32x4){0.f, 0.f, 0.f, 0.f};
#pragma unroll
        for (int m = 0; m < 5; ++m) {
            const u32x4 pw = (u32x4){pk2(s[2 * m][0], s[2 * m][1]), pk2(s[2 * m][2], s[2 * m][3]), pk2(s[2 * m + 1][0], s[2 * m + 1][1]), pk2(s[2 * m + 1][2], s[2 * m + 1][3])};
            const bf16x8 pb = __builtin_bit_cast(bf16x8, pw); const int T0 = qt + 2 * m;
#pragma unroll
            for (int dt = 0; dt < 4; ++dt) { const LAS unsigned char* vp = Vt + (16 * dt + fr) * AVT_STRIDE + (16 * T0 + 4 * q4) * 2;
                const u32x2 a0 = *(const LAS u32x2*)vp; u32x2 a1 = (u32x2){0u, 0u}; if (m < 4) a1 = *(const LAS u32x2*)(vp + 32);
                const u32x4 aw = (u32x4){a0.x, a0.y, a1.x, a1.y}; o[dt] = MFMA16(__builtin_bit_cast(bf16x8, aw), pb, o[dt]); } }
#pragma unroll
        for (int dt = 0; dt < 4; ++dt) { u32x2 w; w.x = pk2(o[dt][0] * inv, o[dt][1] * inv); w.y = pk2(o[dt][2] * inv, o[dt][3] * inv);
            *(u32x2*)(mix + qtok * 1024 + 640 + hq * 64 + 16 * dt + 4 * q4) = w; }
    }
    __syncthreads();
}
__device__ __forceinline__ void sample_task(const Params& P, int l, int s, const bf16_t* proj, const bf16_t* Bb, const float* lam, bf16_t* zpre, bf16_t* mix, LAS unsigned char* lds, int tid) {
    const int lane = tid & 63, wave = tid >> 6;
    LAS float* pr = (LAS float*)lds;
    LAS float* hst = pr + 2048;
    LAS float* red = hst + 3072;
    LAS float* sc = red + 512 + 16;
    const size_t row = (size_t)MP + s;
    float* out = P.out;
#pragma unroll
    for (int i = 0; i < 4; ++i) { const int c = tid + 512 * i; pr[c] = bf2f(proj[row * INW + c]); }
    __syncthreads();
#pragma unroll
    for (int i = 0; i < 3; ++i) { const int idx = tid + 512 * i, g = idx >> 6, p = idx & 63; const size_t si = ((size_t)(l * 128 + s) * 24 + g) * 64 + p;
        const float h0r = P.in[2][si], h0i = P.in[3][si]; const float lr = lam[(g * 64 + p) * 8], li = lam[(g * 64 + p) * 8 + 1];
        const bf16_t* br = Bb + ((g * 8 + 2 * (p >> 4)) * 16 + (p & 15)) * 16; const bf16_t* bi = br + 256;
        float hr = lr * h0r - li * h0i, hi = lr * h0i + li * h0r;
#pragma unroll
        for (int h = 0; h < 16; ++h) { const float u = pr[C_U + g * 16 + h]; hr += bf2f(br[h]) * u; hi += bf2f(bi[h]) * u; }
        out[O_SSRE + si] = hr; out[O_SSIM + si] = hi; hst[idx * 2] = hr; hst[idx * 2 + 1] = hi; }
    __syncthreads();
    if (tid < 384) { const int g = tid >> 4, hh = tid & 15; const float* cre = P.in[13] + ((size_t)(l * 24 + g) * 16 + hh) * 64; const float* cim = P.in[14] + ((size_t)(l * 24 + g) * 16 + hh) * 64;
        float y = 0.f;
#pragma unroll 4
        for (int p = 0; p < 64; ++p) y += cre[p] * hst[(g * 64 + p) * 2] - cim[p] * hst[(g * 64 + p) * 2 + 1];
        y += P.in[15][l * 384 + tid] * pr[C_U + tid];
        zpre[row * 384 + tid] = (bf16_t)f2bf(gelu_tanh(y)); }
    { const int h = tid >> 7, e = tid & 63, dh = (tid >> 6) & 1; const float gam = 1.0f - exp2f(-5.0f - (float)h);
      const size_t sb = ((size_t)(l * 128 + s) * 4 + h) * 4096; const float ve = pr[C_RV + h * 64 + e];
      float part = 0.f, qk = 0.f;
#pragma unroll 4
      for (int dd = 0; dd < 32; ++dd) { const int d = 32 * dh + dd; const float s0 = P.in[4][sb + d * 64 + e], q = pr[C_RQ + h * 64 + d], k = pr[C_RK + h * 64 + d] * 0.125f;
          out[O_SRET + sb + d * 64 + e] = gam * s0 + k * ve; part += q * s0; qk += q * k; }
      red[(h * 2 + dh) * 64 + e] = part; if (e == 0) red[512 + h * 2 + dh] = qk;
      __syncthreads();
      if (dh == 0) { const float o = (red[512 + h * 2] + red[512 + h * 2 + 1]) * ve + gam * (red[(h * 2) * 64 + e] + red[(h * 2 + 1) * 64 + e]);
          const float mean = wave_sum(o) * (1.f / 64.f); const float dlt = o - mean; const float var = wave_sum(dlt * dlt) * (1.f / 64.f); const float nrm = dlt / sqrtf(var + LN_EPS);
          const float val = siluf_(pr[C_RG + h * 64 + e]) * (nrm * P.in[18][l * 256 + h * 64 + e] + P.in[19][l * 256 + h * 64 + e]);
          mix[row * 1024 + 384 + h * 64 + e] = (bf16_t)f2bf(val); } }
    const float* ck = P.in[5] + (size_t)(l * 128 + s) * 16384; const float* cv = P.in[6] + (size_t)(l * 128 + s) * 16384;
    for (int idx = tid; idx < 6 * 129; idx += 512) { const int hq = idx / 129, j = idx % 129, kvh = hq / 3; float dot = 0.f;
        if (j < 128) { const float* kp = ck + j * 128 + kvh * 64;
#pragma unroll 8
            for (int d = 0; d < 64; ++d) dot += pr[C_AQ + hq * 64 + d] * kp[d]; }
        else {
#pragma unroll 8
            for (int d = 0; d < 64; ++d) dot += pr[C_AQ + hq * 64 + d] * pr[C_AK + kvh * 64 + d]; }
        sc[hq * 132 + j] = dot * 0.125f - alibi_slope(hq) * (float)(128 - j); }
    __syncthreads();
    if (wave < 6) { const int hq = wave; const float sink = P.in[20][l * 6 + hq]; float mx = sink;
        for (int j = lane; j < 129; j += 64) mx = fmaxf(mx, sc[hq * 132 + j]);
#pragma unroll
        for (int o = 1; o < 64; o <<= 1) mx = fmaxf(mx, __shfl_xor(mx, o));
        float den = 0.f;
        for (int j = lane; j < 129; j += 64) { const float e = __expf(sc[hq * 132 + j] - mx); sc[hq * 132 + j] = e; den += e; }
        den = wave_sum(den) + __expf(sink - mx); const float inv = 1.f / den;
        for (int j = lane; j < 129; j += 64) sc[hq * 132 + j] *= inv; }
    __syncthreads();
    if (tid < 384) { const int hq = tid >> 6, d = tid & 63, kvh = hq / 3; float o = 0.f;
#pragma unroll 8
        for (int j = 0; j < 128; ++j) o += sc[hq * 132 + j] * cv[j * 128 + kvh * 64 + d];
        o += sc[hq * 132 + 128] * pr[C_AV + kvh * 64 + d];
        mix[row * 1024 + 640 + hq * 64 + d] = (bf16_t)f2bf(o); }
    { float* ok = out + O_SWK + (size_t)(l * 128 + s) * 16384; float* ov = out + O_SWV + (size_t)(l * 128 + s) * 16384;
#pragma unroll 2
      for (int i = 0; i < 8; ++i) { const int q = tid + 512 * i, j = q >> 5, c4 = (q & 31) * 4;
          f32x4 a, b2;
          if (j < 127) { a = *(const f32x4*)(ck + (j + 1) * 128 + c4); b2 = *(const f32x4*)(cv + (j + 1) * 128 + c4); }
          else { a = (f32x4){pr[C_AK + c4], pr[C_AK + c4 + 1], pr[C_AK + c4 + 2], pr[C_AK + c4 + 3]}; b2 = (f32x4){pr[C_AV + c4], pr[C_AV + c4 + 1], pr[C_AV + c4 + 2], pr[C_AV + c4 + 3]}; }
          *(f32x4*)(ok + j * 128 + c4) = a; *(f32x4*)(ov + j * 128 + c4) = b2; } }
    __syncthreads();
}
__global__ void __launch_bounds__(512, 2) fwd_megakernel(Params P) {
    extern __shared__ __attribute__((aligned(16))) unsigned char lds_raw[];
    LAS unsigned char* lds = (LAS unsigned char*)lds_raw;
    cg::grid_group grid = cg::this_grid();
    const int G = gridDim.x, bid = blockIdx.x, NGW = G * 8;
    unsigned char* ws = P.ws; float* out = P.out;
    bf16_t* xb = (bf16_t*)(ws + OFF_XB); bf16_t* proj = (bf16_t*)(ws + OFF_PROJ); bf16_t* zpre = (bf16_t*)(ws + OFF_ZPRE); bf16_t* mix = (bf16_t*)(ws + OFF_MIX); bf16_t* hid = (bf16_t*)(ws + OFF_HID);
    float* KV = (float*)(ws + OFF_KV); float* E = (float*)(ws + OFF_E); float* xres = out;

#define FRESH_TID() int tid = threadIdx.x; asm volatile("" : "+v"(tid)); const int lane = tid & 63, wave = __builtin_amdgcn_readfirstlane(tid >> 6); const int gw = bid * 8 + wave, gwr = (G - 1 - bid) * 8 + wave
    { FRESH_TID(); phase0(P, lds, gw, NGW, wave, lane); }
    grid.sync();

    for (int l = 0; l < 2; ++l) {
        unsigned char* wl = ws + OFF_W + (size_t)l * SZ_WL;
        const bf16_t* WinT = (const bf16_t*)wl; const bf16_t* WoutT = (const bf16_t*)(wl + SZ_WIN); const bf16_t* W13T = (const bf16_t*)(wl + SZ_WIN + SZ_WOUT);
        const bf16_t* W2T = (const bf16_t*)(wl + SZ_WIN + SZ_WOUT + SZ_W13); const bf16_t* GluT = (const bf16_t*)(wl + SZ_WIN + SZ_WOUT + SZ_W13 + SZ_W2);
        const bf16_t* Bb = (const bf16_t*)(ws + OFF_S5C + (size_t)l * SZ_S5C); const bf16_t* Cc = (const bf16_t*)(ws + OFF_S5C + (size_t)l * SZ_S5C + SZ_BB); const float* lam = (const float*)(ws + OFF_S5C + (size_t)l * SZ_S5C + SZ_BB + SZ_CC);

        { pg8::Gemm g{xb, WinT, MPAD, INW, 1024}; pg8::StaticOrder S; S.init(MPAD, INW, G, bid);
          EpiProj Ep{proj, out + O_PWK + (size_t)l * 131072, out + O_PWV + (size_t)l * 131072};
          pg8::gemm_phase<EpiProj, pg8::StaticOrder>(lds, g, S, Ep); }
        grid.sync();

        { FRESH_TID();
        for (int t = bid; t < 256; t += G) swa_task(proj, mix, P.in[20] + l * 6, t >> 5, (t >> 1) & 15, t & 1, lds, tid);
        for (int t = bid; t < 128; t += G) sample_task(P, l, t, proj, Bb, lam, zpre, mix, lds, tid);
        for (int t = gwr; t < 512 + 6144; t += NGW) {
            if (t < 512) ret_kv_task(proj, KV, t >> 6, (t >> 4) & 3, t & 15, lane);
            else { const int u = t - 512; const int tile = u & 31, bg = u >> 5; s5_tile<1>(proj, Bb, Cc, lam, nullptr, E, nullptr, nullptr, nullptr, bg / 24, bg % 24, tile, lds, lane); }
        }
        }
        grid.sync();

        { FRESH_TID();
        for (int t = bid; t < 512; t += G) ret_out_task(proj, KV, mix, P.in[18] + l * 256, P.in[19] + l * 256, out + O_PRET + (size_t)l * 131072, t >> 6, (t >> 4) & 3, t & 15, lds, tid);
        for (int t = gwr; t < 6144; t += NGW) { const int tile = t & 31, bg = t >> 5;
            s5_tile<2>(proj, Bb, Cc, lam, P.in[15] + l * 384, E, zpre, out + O_PSRE + (size_t)l * 12288, out + O_PSIM + (size_t)l * 12288, bg / 24, bg % 24, tile, lds + wave * 17408, lane); }
        }
        grid.sync();

        { pg8::Gemm g{zpre, GluT, MPAD, 512, 384}; pg8::StaticOrder S; S.init(MPAD, 512, G, bid);
          EpiGlu Ep{zpre, mix, P.in[17] + l * 384};
          pg8::gemm_phase<EpiGlu, pg8::StaticOrder>(lds, g, S, Ep); }
        grid.sync();

        { pg8::Gemm g{mix, WoutT, MPAD, 1024, 1024}; pg8::StaticOrder S; S.init(MPAD, 1024, G, bid);
          EpiResid Ep{P.in[0], l == 0 ? P.in[1] : nullptr, xres};
          pg8::gemm_phase<EpiResid, pg8::StaticOrder>(lds, g, S, Ep); }
        grid.sync();
        { FRESH_TID(); ln_phase(xres, xb, P.in[22] + l * 1024, P.in[23] + l * 1024, gw, NGW, lane); }
        grid.sync();

        { pg8::Gemm g{xb, W13T, MPAD, 5632, 1024}; pg8::StaticOrder S; S.init(MPAD, 5632, G, bid);
          EpiSwiglu Ep{hid};
          pg8::gemm_phase<EpiSwiglu, pg8::StaticOrder>(lds, g, S, Ep); }
        grid.sync();
        { pg8::Gemm g{hid, W2T, MPAD, 1024, FF}; pg8::StaticOrder S; S.init(MPAD, 1024, G, bid);
          EpiResid Ep{P.in[0], nullptr, xres};
          pg8::gemm_phase<EpiResid, pg8::StaticOrder>(lds, g, S, Ep); }
        grid.sync();
        { FRESH_TID(); ln_phase(xres, xb, P.in[27] + l * 1024, P.in[28] + l * 1024, gw, NGW, lane); }
        grid.sync();
    }
}

extern "C" void kernel_launch(void* const* d_in, const int* in_sizes, int n_in, void* d_out, int out_size, void* d_ws, size_t ws_size, hipStream_t stream) {
    static int grid_blocks = 0;
    if (!grid_blocks) {
        int dev = 0, cus = 0, per_cu = 0;
        hipGetDevice(&dev);
        hipDeviceGetAttribute(&cus, hipDeviceAttributeMultiprocessorCount, dev);
        hipFuncSetAttribute((const void*)fwd_megakernel, hipFuncAttributeMaxDynamicSharedMemorySize, LDS_BYTES);
        hipOccupancyMaxActiveBlocksPerMultiprocessor(&per_cu, (const void*)fwd_megakernel, 512, LDS_BYTES);
        if (per_cu < 1) per_cu = 1;
        grid_blocks = cus * per_cu;
        if (ws_size < WS_END) { fprintf(stderr, "kernel_launch: workspace too small (%zu < %zu)\n", ws_size, (size_t)WS_END); }
    }
    Params p{};
    for (int i = 0; i < 29; ++i) p.in[i] = (const float*)d_in[i];
    p.out = (float*)d_out; p.ws = (unsigned char*)d_ws;
    void* args[] = {&p};
    hipError_t e = hipLaunchCooperativeKernel((const void*)fwd_megakernel, dim3(grid_blocks), dim3(512), args, LDS_BYTES, stream);
    if (e != hipSuccess) fprintf(stderr, "cooperative launch failed: %s (grid %d)\n", hipGetErrorString(e), grid_blocks);
}
```

```cpp
#include <hip/hip_runtime.h>
#include <hip/hip_cooperative_groups.h>
#include <cstdio>
namespace cg = cooperative_groups;
namespace pg8 {
#define PG8_LAS __attribute__((address_space(3)))
typedef unsigned short bf16_t;
typedef short bf16x8 __attribute__((ext_vector_type(8)));
typedef float f32x4 __attribute__((ext_vector_type(4)));
typedef unsigned u32x4 __attribute__((ext_vector_type(4)));
constexpr int BM = 256, BK = 64, HALF = 128, HTB = HALF * BK * 2  , STAGE_BYTES = 8 * HTB, NXCD = 8, WGM = 8;

__host__ __device__ __forceinline__ int lds_byte(int r, int c) { const int st = (r >> 4) * 2 + (c >> 5), rr = r & 15, cc = c & 31, ob = rr * 64 + cc * 2; return st * 1024 + (ob ^ (((ob >> 9) & 1) << 5)); }
__host__ __device__ __forceinline__ void stage_rc(int b, int& R, int& C) { const int st = b / 1024, sb = b % 1024, swz = sb ^ (((sb >> 9) & 1) << 5); R = (st >> 1) * 16 + swz / 64; C = (st & 1) * 32 + (swz % 64) / 2; }
__host__ __device__ __forceinline__ int perm32(int rho) { const int n = rho >> 4, i = rho & 15; return 8 * (i >> 2) + 4 * n + (i & 3); }

struct Unit { int pm, pn; };
struct Gemm { const bf16_t* A; const bf16_t* Bt; int M, N, K; };

struct StaticOrder {
    int nM, nN, nwg, G, c;
    __host__ __device__ void init(int M, int N, int G_, int c_) { nM = M / BM; nN = N / BM; nwg = nM * nN; G = G_; c = c_; }
    __host__ __device__ bool next(int i, Unit& u) const {
        const long L = (long)i * G + c; if (L >= nwg) return false;
        int wgid = (int)L; { const int q = nwg / NXCD, r = nwg % NXCD, xcd = wgid % NXCD, off = wgid / NXCD; wgid = (xcd < r ? xcd * (q + 1) : r * (q + 1) + (xcd - r) * q) + off; }
        const int nig = WGM * nN, gid = wgid / nig, fm = gid * WGM, gsz = (nM - fm) < WGM ? (nM - fm) : WGM;
        u.pm = fm + ((wgid % nig) % gsz); u.pn = (wgid % nig) / gsz; return true;
    }
    __device__ __forceinline__ void a_ready(const Unit&) const {}
    __device__ __forceinline__ void done(const Unit&) const {}
};
__device__ __forceinline__ unsigned cvt_pk_bf16(float lo, float hi) { unsigned r; asm volatile("v_cvt_pk_bf16_f32 %0, %1, %2" : "=v"(r) : "v"(lo), "v"(hi)); return r; }
typedef float f32x2 __attribute__((ext_vector_type(2)));
template <class Epi, class Sched>
__device__ __forceinline__ void gemm_phase(PG8_LAS unsigned char* lds, const Gemm g, const Sched& S, const Epi& E, int tid_in) {
    int tid_raw = tid_in; asm volatile("" : "+v"(tid_raw)); const int tid = tid_raw, wid = __builtin_amdgcn_readfirstlane(tid >> 6), lane = tid & 63, wr = wid >> 2, wc = wid & 3, fr = lane & 15, fq = lane >> 4;
    const int K = g.K, nt = K / BK;
    unsigned voffA[2], voffB[2];
#pragma unroll
    for (int i = 0; i < 2; ++i) { int R, C; stage_rc(tid * 16 + i * 8192, R, C); const int Rb = Epi::PERM ? ((R & ~31) + perm32(R & 31)) : R;
        voffA[i] = (unsigned)(R * K + C) * 2u; voffB[i] = (unsigned)(Rb * K + C) * 2u; }
    const size_t kstep = (size_t)(BK * 2);
    const size_t hstep = (size_t)HALF * K * 2;
    const size_t tstep = 2 * hstep;
    const unsigned ldsw = (unsigned)wid * 1024u;
    const int aoff = lds_byte(wr * 64 + fr, fq * 8), boff = lds_byte(wc * 32 + fr, fq * 8);
#define PG8_SA(b, h) (((b) * 2 + (h)) * HTB)
#define PG8_SB(b, h) ((4 + (b) * 2 + (h)) * HTB)
#define PG8_STAGE(bufoff, gbase, voff) do { _Pragma("unroll") for (int _i = 0; _i < 2; ++_i) \
        __builtin_amdgcn_global_load_lds((const unsigned*)((const char*)(gbase) + (voff)[_i]), (PG8_LAS unsigned*)(lds + (bufoff) + ldsw + _i * 8192), 16, 0, 0); } while (0)
#define PG8_LDA(dst, b, h) do { _Pragma("unroll") for (int m = 0; m < 4; ++m) _Pragma("unroll") for (int k = 0; k < 2; ++k) dst[m][k] = *(const PG8_LAS bf16x8*)(lds + PG8_SA(b, h) + aoff + m * 2048 + k * 1024); } while (0)
#define PG8_LDB(dst, b, h) do { _Pragma("unroll") for (int n = 0; n < 2; ++n) _Pragma("unroll") for (int k = 0; k < 2; ++k) dst[n][k] = *(const PG8_LAS bf16x8*)(lds + PG8_SB(b, h) + boff + n * 2048 + k * 1024); } while (0)
#define PG8_MMA(ai, bj, At, Bt) do { __builtin_amdgcn_s_setprio(1); _Pragma("unroll") for (int m = 0; m < 4; ++m) _Pragma("unroll") for (int n = 0; n < 2; ++n) _Pragma("unroll") for (int k = 0; k < 2; ++k) \
        acc[ai][bj][m][n] = __builtin_amdgcn_mfma_f32_16x16x32_bf16(Bt[n][k], At[m][k], acc[ai][bj][m][n], 0, 0, 0); __builtin_amdgcn_s_setprio(0); } while (0)
#define PG8_WAIT_V(n) asm volatile("s_waitcnt vmcnt(" #n ")" ::: "memory")
#define PG8_WAIT_L(n) asm volatile("s_waitcnt lgkmcnt(" #n ")" ::: "memory")
#define PG8_BAR __builtin_amdgcn_s_barrier()
#define PG8_SCHED __builtin_amdgcn_sched_barrier(0)
    Unit cur, nxt; int ui = 0;
    if (!S.next(0, cur)) return;
    f32x4 acc[2][2][4][2];
#pragma unroll
    for (int a = 0; a < 2; ++a)
#pragma unroll
        for (int b = 0; b < 2; ++b)
#pragma unroll
            for (int m = 0; m < 4; ++m)
#pragma unroll
                for (int n = 0; n < 2; ++n) acc[a][b][m][n] = (f32x4){0.f, 0.f, 0.f, 0.f};
    bf16x8 At[4][2], B0[2][2], B1[2][2];
    const char* cA = (const char*)g.A + (size_t)cur.pm * tstep; const char* cB = (const char*)g.Bt + (size_t)cur.pn * tstep;
    S.a_ready(cur);
    PG8_STAGE(PG8_SB(0, 0), cB, voffB); PG8_STAGE(PG8_SA(0, 0), cA, voffA); PG8_STAGE(PG8_SB(0, 1), cB + hstep, voffB); PG8_STAGE(PG8_SA(0, 1), cA + hstep, voffA);
    if (wr == 1) PG8_BAR;
    PG8_WAIT_V(4); PG8_BAR;
    PG8_STAGE(PG8_SB(1, 0), cB + kstep, voffB); PG8_STAGE(PG8_SA(1, 0), cA + kstep, voffA); PG8_STAGE(PG8_SB(1, 1), cB + hstep + kstep, voffB);
    PG8_WAIT_V(6); PG8_BAR;
    for (;;) {
        const bool has_next = S.next(ui + 1, nxt);
        const char* nA = has_next ? (const char*)g.A + (size_t)nxt.pm * tstep : cA; const char* nB = has_next ? (const char*)g.Bt + (size_t)nxt.pn * tstep : cB;
#pragma unroll 1
        for (int t = 0; t < nt; t += 2) {
            const bool last = (t == nt - 2);
            const char* a1 = cA + (size_t)(t + 1) * kstep;
            const char* a2 = last ? nA : cA + (size_t)(t + 2) * kstep; const char* b2 = last ? nB : cB + (size_t)(t + 2) * kstep;
            const char* a3 = a2 + kstep; const char* b3 = b2 + kstep;
            if (last && has_next) S.a_ready(nxt);
            PG8_LDB(B0, 0, 0); PG8_SCHED; PG8_LDA(At, 0, 0); PG8_STAGE(PG8_SA(1, 1), a1 + hstep, voffA);
            PG8_WAIT_L(8); PG8_BAR; PG8_WAIT_L(0); PG8_MMA(0, 0, At, B0); PG8_BAR; PG8_SCHED;
            PG8_LDB(B1, 0, 1); PG8_STAGE(PG8_SB(0, 0), b2, voffB);
            PG8_BAR; PG8_WAIT_L(0); PG8_MMA(0, 1, At, B1); PG8_BAR;
            PG8_LDA(At, 0, 1); PG8_STAGE(PG8_SA(0, 0), a2, voffA);
            PG8_BAR; PG8_WAIT_L(0); PG8_MMA(1, 0, At, B0); PG8_BAR; PG8_SCHED;
            PG8_STAGE(PG8_SB(0, 1), b2 + hstep, voffB);
            PG8_WAIT_V(6); PG8_BAR; PG8_MMA(1, 1, At, B1); PG8_BAR;
            PG8_LDB(B0, 1, 0); PG8_SCHED; PG8_LDA(At, 1, 0); PG8_STAGE(PG8_SA(0, 1), a2 + hstep, voffA);
            PG8_WAIT_L(8); PG8_BAR; PG8_WAIT_L(0); PG8_MMA(0, 0, At, B0); PG8_BAR; PG8_SCHED;
            PG8_LDB(B1, 1, 1); PG8_STAGE(PG8_SB(1, 0), b3, voffB);
            PG8_BAR; PG8_WAIT_L(0); PG8_MMA(0, 1, At, B1); PG8_BAR;
            PG8_LDA(At, 1, 1); PG8_STAGE(PG8_SA(1, 0), a3, voffA);
            PG8_BAR; PG8_WAIT_L(0); PG8_MMA(1, 0, At, B0); PG8_BAR; PG8_SCHED;
            PG8_STAGE(PG8_SB(1, 1), b3 + hstep, voffB);
            PG8_WAIT_V(6); PG8_BAR; PG8_MMA(1, 1, At, B1); PG8_BAR;
        }
        if constexpr (!Epi::AFTER_DRAIN) { E(acc, cur, wr, wc, fr, fq); S.done(cur); }
        if (!has_next) break;
#pragma unroll
        for (int a = 0; a < 2; ++a)
#pragma unroll
            for (int b = 0; b < 2; ++b)
#pragma unroll
                for (int m = 0; m < 4; ++m)
#pragma unroll
                    for (int n = 0; n < 2; ++n) acc[a][b][m][n] = (f32x4){0.f, 0.f, 0.f, 0.f};
        cur = nxt; cA = nA; cB = nB; ++ui;
    }
    PG8_WAIT_V(0);
    if (wr == 0) PG8_BAR;
    PG8_BAR;
    if constexpr (Epi::AFTER_DRAIN) { E.fused(acc, cur, wr, wc, fr, fq, lds, wid, lane); S.done(cur); }
#undef PG8_SA
#undef PG8_SB
#undef PG8_STAGE
#undef PG8_LDA
#undef PG8_LDB
#undef PG8_MMA
#undef PG8_WAIT_V
#undef PG8_WAIT_L
#undef PG8_BAR
#undef PG8_SCHED
}
}
using pg8::bf16_t; using pg8::bf16x8; using pg8::f32x4; using pg8::u32x4; using pg8::Unit;
typedef unsigned u32x2 __attribute__((ext_vector_type(2)));
#define LAS __attribute__((address_space(3)))
#define MFMA16(a, b, c) __builtin_amdgcn_mfma_f32_16x16x32_bf16((a), (b), (c), 0, 0, 0)
#define LDS_WAIT() asm volatile("s_waitcnt lgkmcnt(0)" ::: "memory")

constexpr int DM = 1024, NB = 8, SEQ = 2048, MP = NB * SEQ, MS = 128, MT = MP + MS, MPAD = 16640;
constexpr int INW = 2048, FF = 2816;
constexpr int C_U = 0, C_RQ = 384, C_RK = 640, C_RV = 896, C_RG = 1152, C_AQ = 1408, C_AK = 1792, C_AV = 1920;
constexpr float ALPHA = 1.41421356237f;
constexpr float LN_EPS = 1e-5f;
constexpr int LDS_BYTES = 147456;

constexpr size_t SZ_WIN = (size_t)2048 * 1024 * 2, SZ_WOUT = (size_t)1024 * 1024 * 2, SZ_W13 = (size_t)5632 * 1024 * 2, SZ_W2 = (size_t)1024 * 2816 * 2, SZ_GLU = (size_t)512 * 384 * 2;
constexpr size_t SZ_WL = SZ_WIN + SZ_WOUT + SZ_W13 + SZ_W2 + SZ_GLU;
constexpr size_t OFF_W = 1u << 20;
constexpr size_t SZ_BB = 24 * 8 * 16 * 16 * 2, SZ_CC = 24 * 16 * 128 * 2, SZ_LAM = 24 * 64 * 8 * 4, SZ_S5C = SZ_BB + SZ_CC + SZ_LAM;
constexpr size_t OFF_S5C = OFF_W + 2 * SZ_WL;
constexpr size_t OFF_XB = (OFF_S5C + 2 * SZ_S5C + 4095) / 4096 * 4096;
constexpr size_t SZ_XB = (size_t)MPAD * 1024 * 2;
constexpr size_t OFF_KV = OFF_XB + SZ_XB;
constexpr size_t SZ_KV = (size_t)8 * 4 * 16 * 4096 * 4;
constexpr size_t OFF_E = OFF_KV + SZ_KV;
constexpr size_t SZ_E = (size_t)8 * 32 * 24 * 128 * 4;
constexpr size_t OFF_PROJ = OFF_E + SZ_E;
constexpr size_t SZ_PROJ = (size_t)MPAD * 2048 * 2;
constexpr size_t OFF_ZPRE = OFF_PROJ + SZ_PROJ;
constexpr size_t SZ_ZPRE = (size_t)MPAD * 384 * 2;
constexpr size_t OFF_MIX = OFF_ZPRE + SZ_ZPRE;
constexpr size_t SZ_MIX = (size_t)MPAD * 1024 * 2;
constexpr size_t OFF_HID = OFF_PROJ;
constexpr size_t SZ_HID = (size_t)MPAD * FF * 2;
constexpr size_t WS_END = OFF_MIX + SZ_MIX;
static_assert(SZ_HID <= SZ_PROJ + SZ_ZPRE + SZ_MIX, "hid overlay");
static_assert(WS_END <= 268435456, "ws");

constexpr size_t O_YP = 0, O_YS = 16777216, O_PSRE = 16908288, O_PSIM = 16932864, O_PRET = 16957440, O_PWK = 17219584, O_PWV = 17481728,
                 O_SSRE = 17743872, O_SSIM = 18137088, O_SRET = 18530304, O_SWK = 22724608, O_SWV = 26918912;

__device__ __forceinline__ unsigned f2bf(float f) { unsigned u = __builtin_bit_cast(unsigned, f); return (u + 0x7fffu + ((u >> 16) & 1u)) >> 16; }
__device__ __forceinline__ unsigned pk2(float lo, float hi) { return f2bf(lo) | (f2bf(hi) << 16); }
__device__ __forceinline__ float bf2f(unsigned short b) { return __builtin_bit_cast(float, ((unsigned)b) << 16); }
__device__ __forceinline__ float bflo(unsigned w) { return __builtin_bit_cast(float, w << 16); }
__device__ __forceinline__ float bfhi(unsigned w) { return __builtin_bit_cast(float, w & 0xffff0000u); }
__device__ __forceinline__ float sigmoidf_(float x) { return __builtin_amdgcn_rcpf(1.0f + __expf(-x)); }
__device__ __forceinline__ float siluf_(float x) { return x * sigmoidf_(x); }
__device__ __forceinline__ float gelu_tanh(float x) { const float u = 0.7978845608f * (x + 0.044715f * x * x * x); const float t = 1.0f - 2.0f / (__expf(2.0f * u) + 1.0f); return 0.5f * x * (1.0f + t); }
__device__ __forceinline__ float wave_sum(float v) {
#pragma unroll
    for (int o = 1; o < 64; o <<= 1) v += __shfl_xor(v, o);
    return v;
}

struct Params { const float* in[29]; float* out; unsigned char* ws; };

struct EpiProj {
    static constexpr bool PERM = true, AFTER_DRAIN = false;
    bf16_t* O;
    __device__ __forceinline__ void operator()(const f32x4 (&acc)[2][2][4][2], const Unit& u, int wr, int wc, int fr, int fq) const {
        const int row0 = u.pm * 256 + wr * 64 + fr, col0 = u.pn * 256 + wc * 32 + 8 * fq;
#pragma unroll
        for (int ai = 0; ai < 2; ++ai)
#pragma unroll
            for (int m = 0; m < 4; ++m) { bf16_t* rowp = O + (size_t)(row0 + ai * 128 + m * 16) * INW + col0;
#pragma unroll
                for (int bj = 0; bj < 2; ++bj) { const f32x4 v0 = acc[ai][bj][m][0], v1 = acc[ai][bj][m][1];
                    u32x4 w; w.x = pk2(v0[0], v0[1]); w.y = pk2(v0[2], v0[3]); w.z = pk2(v1[0], v1[1]); w.w = pk2(v1[2], v1[3]);
                    *(u32x4*)(rowp + bj * 128) = w; } asm volatile("" ::: "memory"); }
    }
};
struct EpiGlu {
    static constexpr bool PERM = true, AFTER_DRAIN = false;
    const bf16_t* Z; bf16_t* O; const float* bias;
    __device__ __forceinline__ void operator()(const f32x4 (&acc)[2][2][4][2], const Unit& u, int wr, int wc, int fr, int fq) const {
        const int row0 = u.pm * 256 + wr * 64 + fr, col0 = u.pn * 256 + wc * 32 + 8 * fq;
#pragma unroll
        for (int bj = 0; bj < 2; ++bj) { const int c = col0 + bj * 128; if (c >= 384) continue;
#pragma unroll
            for (int n = 0; n < 2; ++n) { const f32x4 b0 = *(const f32x4*)(bias + c + 4 * n);
#pragma unroll
                for (int ai = 0; ai < 2; ++ai)
#pragma unroll
                    for (int m = 0; m < 4; ++m) { const size_t row = (size_t)(row0 + ai * 128 + m * 16);
                        const u32x2 z = *(const u32x2*)(Z + row * 384 + c + 4 * n); const f32x4 v0 = acc[ai][bj][m][n] + b0;
                        u32x2 w;
                        w.x = pk2(bflo(z.x) * sigmoidf_(v0[0]), bfhi(z.x) * sigmoidf_(v0[1])); w.y = pk2(bflo(z.y) * sigmoidf_(v0[2]), bfhi(z.y) * sigmoidf_(v0[3]));
                        *(u32x2*)(O + row * 1024 + c + 4 * n) = w; asm volatile("" ::: "memory"); } } }
    }
};
struct EpiResid {
    static constexpr bool PERM = false, AFTER_DRAIN = false;
    const float* xp; const float* xs; float* xres;
    __device__ __forceinline__ void operator()(const f32x4 (&acc)[2][2][4][2], const Unit& u, int wr, int wc, int fr, int fq) const {
        const int row0 = u.pm * 256 + wr * 64 + fr, col0 = u.pn * 256 + wc * 32 + 4 * fq;
#pragma unroll
        for (int ai = 0; ai < 2; ++ai)
#pragma unroll
            for (int m = 0; m < 4; ++m) { const int row = row0 + ai * 128 + m * 16; if (row >= MT) continue;
                const float* bp = xs ? (row < MP ? xp + (size_t)row * 1024 : xs + (size_t)(row - MP) * 1024) : xres + (size_t)row * 1024; float* op = xres + (size_t)row * 1024;
#pragma unroll
                for (int bj = 0; bj < 2; ++bj)
#pragma unroll
                    for (int n = 0; n < 2; ++n) { const int c = col0 + bj * 128 + n * 16; const f32x4 bs = *(const f32x4*)(bp + c); *(f32x4*)(op + c) = bs * ALPHA + acc[ai][bj][m][n]; } asm volatile("" ::: "memory"); }
    }
};
struct EpiSwiglu {
    static constexpr bool PERM = true, AFTER_DRAIN = false;
    bf16_t* H;
    __device__ __forceinline__ void operator()(const f32x4 (&acc)[2][2][4][2], const Unit& u, int wr, int wc, int fr, int fq) const {
        const int row0 = u.pm * 256 + wr * 64 + fr, col0 = u.pn * 128 + wc * 32 + 8 * fq;
#pragma unroll
        for (int ai = 0; ai < 2; ++ai)
#pragma unroll
            for (int m = 0; m < 4; ++m) { const size_t row = (size_t)(row0 + ai * 128 + m * 16);
                const f32x4 a0 = acc[ai][0][m][0], a1 = acc[ai][0][m][1], g0 = acc[ai][1][m][0], g1 = acc[ai][1][m][1];
                u32x4 w; w.x = pk2(siluf_(a0[0]) * g0[0], siluf_(a0[1]) * g0[1]); w.y = pk2(siluf_(a0[2]) * g0[2], siluf_(a0[3]) * g0[3]);
                w.z = pk2(siluf_(a1[0]) * g1[0], siluf_(a1[1]) * g1[1]); w.w = pk2(siluf_(a1[2]) * g1[2], siluf_(a1[3]) * g1[3]);
                *(u32x4*)(H + row * FF + col0) = w; asm volatile("" ::: "memory"); }
    }
};
#define XB_TMO      128
#define XB_XCNT(j)  (256  + 64 * (j))
#define XB_XSUB(j)  (1280 + 64 * (j))
#define XB_XGEN(j)  (2304 + 64 * (j))
#define XB_TOP      3328
#define XB_TOPGEN   3392
#define XCD_BAR_WORDS 3456
#define XB_SPIN_CAP (1u << 18)

__device__ __forceinline__ unsigned xb_ld(unsigned* p)              { return __hip_atomic_load(p, __ATOMIC_RELAXED, __HIP_MEMORY_SCOPE_AGENT); }
__device__ __forceinline__ unsigned xb_add(unsigned* p, unsigned v) { return __hip_atomic_fetch_add(p, v, __ATOMIC_RELAXED, __HIP_MEMORY_SCOPE_AGENT); }
__device__ __forceinline__ unsigned xb_xcc_id() { return (unsigned)__builtin_amdgcn_s_getreg((3 << 11) | 20) & 0xFu; }
#define XB_SPIN(cond, bar) do { unsigned _sp = 0; while (cond) { __builtin_amdgcn_s_sleep(1); \
    if ((++_sp & 255u) == 0u) { if (xb_ld(&(bar)[XB_TMO])) break; if (_sp > XB_SPIN_CAP) { atomicAdd(&(bar)[XB_TMO], 1u); break; } } } } while (0)

struct XcdBarrier {
    unsigned* bar; unsigned x;
    volatile LAS unsigned* st;
};

__device__ __forceinline__ XcdBarrier xcd_barrier_post(unsigned* bar, volatile LAS unsigned* st) {
    XcdBarrier b; b.bar = bar; b.x = xb_xcc_id(); b.st = st;
    if (threadIdx.x == 0) (void)xb_add(&bar[XB_XCNT(b.x)], 1u);
    return b;
}
__device__ __forceinline__ void xcd_barrier_complete(unsigned* bar, unsigned x, unsigned& nloc, unsigned& nx) {
    const unsigned G = gridDim.x * gridDim.y * gridDim.z;
    unsigned sum, cnt, mine, sp = 0u;
    for (;;) {
        sum = 0u; cnt = 0u; mine = 0u;
#pragma unroll
        for (unsigned j = 0; j < 16; ++j) { const unsigned c = xb_ld(&bar[XB_XCNT(j)]); sum += c; cnt += (c > 0u) ? 1u : 0u; mine = (j == x) ? c : mine; }
        if (sum == G) break;
        __builtin_amdgcn_s_sleep(1);
        if ((++sp & 255u) == 0u) { if (xb_ld(&bar[XB_TMO])) break; if (sp > XB_SPIN_CAP) { atomicAdd(&bar[XB_TMO], 1u); break; } }
    }
    nloc = mine > 0u ? mine : 1u; nx = cnt > 0u ? cnt : 1u;
}

__device__ __forceinline__ void xcd_barrier(const XcdBarrier& b) {
    asm volatile("s_waitcnt vmcnt(0)" ::: "memory");
    __syncthreads();
    if (threadIdx.x == 0) {
        unsigned* bar = b.bar;
        __builtin_amdgcn_s_waitcnt(0);
        unsigned nloc = b.st[0], nx = b.st[1];
        if (nloc == 0u) { xcd_barrier_complete(bar, b.x, nloc, nx); b.st[0] = nloc; b.st[1] = nx; }
        const unsigned old = xb_add(&bar[XB_XSUB(b.x)], 1u);
        const unsigned gen = old / nloc;
        if (old + 1u == (gen + 1u) * nloc) {
            __builtin_amdgcn_fence(__ATOMIC_RELEASE, "agent");
            asm volatile("s_waitcnt vmcnt(0)" ::: "memory");
            const unsigned og = xb_add(&bar[XB_TOP], 1u);
            const unsigned tg = og / nx;
            if (og + 1u == (tg + 1u) * nx) xb_add(&bar[XB_TOPGEN], 1u);
            else XB_SPIN(xb_ld(&bar[XB_TOPGEN]) == tg, bar);
            __builtin_amdgcn_fence(__ATOMIC_ACQUIRE, "agent");
            xb_add(&bar[XB_XGEN(b.x)], 1u);
            asm volatile("s_waitcnt vmcnt(0)" ::: "memory");
        } else {
            XB_SPIN(xb_ld(&bar[XB_XGEN(b.x)]) == gen, bar);
            __builtin_amdgcn_fence(__ATOMIC_ACQUIRE, "agent");
            asm volatile("s_waitcnt vmcnt(0)" ::: "memory");
        }
    }
    __syncthreads();
}
__device__ __forceinline__ void transpose_item(const float* W, int K, int N, bf16_t* WT, int mode, LAS float* scr, int item, int lane) {
    const int nblk = N / 32, kb = item / nblk, nb = item % nblk, k0 = 64 * kb, n0 = 32 * nb;
#pragma unroll 8
    for (int i = 0; i < 32; ++i) { const int kk = 2 * i + (lane >> 5); scr[kk * 33 + (lane & 31)] = W[(size_t)(k0 + kk) * N + n0 + (lane & 31)]; }
    LDS_WAIT();
    const int c = lane & 7;
#pragma unroll
    for (int j = 0; j < 4; ++j) { const int n = (lane >> 3) + 8 * j; const LAS float* s = scr + (8 * c) * 33 + n;
        u32x4 o; o.x = pk2(s[0 * 33], s[1 * 33]); o.y = pk2(s[2 * 33], s[3 * 33]); o.z = pk2(s[4 * 33], s[5 * 33]); o.w = pk2(s[6 * 33], s[7 * 33]);
        const int nn = n0 + n; const int row = mode == 0 ? nn : ((nn >> 7) * 256 + (mode == 2 ? 128 : 0) + (nn & 127));
        *(u32x4*)(WT + (size_t)row * K + k0 + 8 * c) = o; }
    LDS_WAIT();
}
__device__ __forceinline__ void sincos_d(double x, double& s, double& c) {
    const double TWO_PI = 6.283185307179586476925287; x -= TWO_PI * rint(x / TWO_PI);
    const double y = x * 0.125, y2 = y * y;
    double sn = y * (1.0 + y2 * (-1.0 / 6 + y2 * (1.0 / 120 + y2 * (-1.0 / 5040 + y2 * (1.0 / 362880 + y2 * (-1.0 / 39916800 + y2 * (1.0 / 6227020800.0)))))));
    double cs = 1.0 + y2 * (-0.5 + y2 * (1.0 / 24 + y2 * (-1.0 / 720 + y2 * (1.0 / 40320 + y2 * (-1.0 / 3628800 + y2 * (1.0 / 479001600.0))))));
#pragma unroll
    for (int i = 0; i < 3; ++i) { const double s2 = 2.0 * sn * cs, c2 = 1.0 - 2.0 * sn * sn; sn = s2; cs = c2; }
    s = sn; c = cs;
}
__device__ __forceinline__ void phase0(const Params& P, LAS unsigned char* lds, int gw, int NGW, int wave, int lane) {
    unsigned char* ws = P.ws;
    LAS float* scr = (LAS float*)(lds + wave * 16384);
    constexpr int I_IN = 16 * 64, I_OUT = 16 * 32, I_W1 = 16 * 88, I_W2 = 44 * 32, I_GL = 6 * 12, I_L = I_IN + I_OUT + 2 * I_W1 + I_W2 + I_GL;
    for (int it = gw; it < 2 * I_L; it += NGW) {
        const int l = it / I_L; int r = it % I_L; unsigned char* wl = ws + OFF_W + (size_t)l * SZ_WL;
        if (r < I_IN) { transpose_item(P.in[7] + (size_t)l * 1024 * 2048, 1024, 2048, (bf16_t*)wl, 0, scr, r, lane); continue; } r -= I_IN;
        if (r < I_OUT) { transpose_item(P.in[21] + (size_t)l * 1024 * 1024, 1024, 1024, (bf16_t*)(wl + SZ_WIN), 0, scr, r, lane); continue; } r -= I_OUT;
        if (r < I_W1) { transpose_item(P.in[24] + (size_t)l * 1024 * FF, 1024, FF, (bf16_t*)(wl + SZ_WIN + SZ_WOUT), 1, scr, r, lane); continue; } r -= I_W1;
        if (r < I_W1) { transpose_item(P.in[25] + (size_t)l * 1024 * FF, 1024, FF, (bf16_t*)(wl + SZ_WIN + SZ_WOUT), 2, scr, r, lane); continue; } r -= I_W1;
        if (r < I_W2) { transpose_item(P.in[26] + (size_t)l * FF * 1024, FF, 1024, (bf16_t*)(wl + SZ_WIN + SZ_WOUT + SZ_W13), 0, scr, r, lane); continue; } r -= I_W2;
        transpose_item(P.in[16] + (size_t)l * 384 * 384, 384, 384, (bf16_t*)(wl + SZ_WIN + SZ_WOUT + SZ_W13 + SZ_W2), 0, scr, r, lane);
    }
    const int gt = gw * 64 + lane, NGT = NGW * 64;
    for (int i = gt; i < 2 * 6144; i += NGT) { const int l = i / 6144, j = i % 6144;
        *(u32x4*)(ws + OFF_W + (size_t)l * SZ_WL + SZ_WIN + SZ_WOUT + SZ_W13 + SZ_W2 + (size_t)384 * 384 * 2 + (size_t)j * 16) = (u32x4){0u, 0u, 0u, 0u}; }
    { bf16_t* xb = (bf16_t*)(ws + OFF_XB);
      for (int i = gt; i < MT * 128; i += NGT) { const size_t e = (size_t)i * 8; const float* src = e < (size_t)MP * 1024 ? P.in[0] + e : P.in[1] + (e - (size_t)MP * 1024);
          const f32x4 a = *(const f32x4*)src, b = *(const f32x4*)(src + 4); u32x4 w; w.x = pk2(a[0], a[1]); w.y = pk2(a[2], a[3]); w.z = pk2(b[0], b[1]); w.w = pk2(b[2], b[3]);
          *(u32x4*)(xb + e) = w; } }
    for (int i = gt; i < 2 * 24 * 64; i += NGT) {
        const int l = i / 1536, g = (i % 1536) / 64, p = i % 64; const int gi = l * 24 + g;
        bf16_t* Bb = (bf16_t*)(ws + OFF_S5C + (size_t)l * SZ_S5C); bf16_t* Cc = (bf16_t*)(ws + OFF_S5C + (size_t)l * SZ_S5C + SZ_BB); float* lam = (float*)(ws + OFF_S5C + (size_t)l * SZ_S5C + SZ_BB + SZ_CC);
        const double a = (double)P.in[8][gi * 64 + p], w = (double)P.in[9][gi * 64 + p], step = exp((double)P.in[10][gi]);
        double s1, c1, s16, c16, s64, c64; sincos_d(w * step, s1, c1); sincos_d(16.0 * w * step, s16, c16); sincos_d(64.0 * w * step, s64, c64);
        const double m1 = exp(a * step), m16 = exp(16.0 * a * step), m64 = exp(64.0 * a * step);
        float* lp = lam + (g * 64 + p) * 8;
        lp[0] = (float)(m1 * c1); lp[1] = (float)(m1 * s1); lp[2] = (float)(m16 * c16); lp[3] = (float)(m16 * s16); lp[4] = (float)(m64 * c64); lp[5] = (float)(m64 * s64); lp[6] = 0.f; lp[7] = 0.f;
        const double nr = m1 * c1 - 1.0, ni = m1 * s1, den = a * a + w * w; const double fr_ = (nr * a + ni * w) / den, fi_ = (ni * a - nr * w) / den;
        const int j = p >> 4, n = p & 15;
        for (int h = 0; h < 16; ++h) { const double br = (double)P.in[11][(size_t)(gi * 64 + p) * 16 + h], bi = (double)P.in[12][(size_t)(gi * 64 + p) * 16 + h];
            Bb[((g * 8 + 2 * j) * 16 + n) * 16 + h] = (bf16_t)f2bf((float)(fr_ * br - fi_ * bi)); Bb[((g * 8 + 2 * j + 1) * 16 + n) * 16 + h] = (bf16_t)f2bf((float)(fr_ * bi + fi_ * br));
            Cc[(g * 16 + h) * 128 + 2 * p] = (bf16_t)f2bf(P.in[13][(size_t)(gi * 16 + h) * 64 + p]); Cc[(g * 16 + h) * 128 + 2 * p + 1] = (bf16_t)f2bf(-P.in[14][(size_t)(gi * 16 + h) * 64 + p]); }
    }
}
__device__ __forceinline__ void ln_phase(float* xres, bf16_t* xb, const float* g, const float* b, int gw, int NGW, int lane) {
    f32x4 gv[4], bv[4];
#pragma unroll
    for (int j = 0; j < 4; ++j) { gv[j] = ((const f32x4*)g)[lane + 64 * j]; bv[j] = ((const f32x4*)b)[lane + 64 * j]; }
    for (int row = gw; row < MT; row += NGW) {
        f32x4* xr = (f32x4*)(xres + (size_t)row * 1024) + lane; f32x4 v[4]; float s = 0.f;
#pragma unroll
        for (int j = 0; j < 4; ++j) { v[j] = xr[64 * j]; s += (v[j][0] + v[j][1]) + (v[j][2] + v[j][3]); }
        const float mean = wave_sum(s) * (1.f / 1024.f); float s2 = 0.f;
#pragma unroll
        for (int j = 0; j < 4; ++j) { v[j] = v[j] - mean; s2 += (v[j][0] * v[j][0] + v[j][1] * v[j][1]) + (v[j][2] * v[j][2] + v[j][3] * v[j][3]); }
        const float rstd = 1.f / sqrtf(wave_sum(s2) * (1.f / 1024.f) + LN_EPS);
        u32x2* o8 = (u32x2*)(xb + (size_t)row * 1024) + lane;
#pragma unroll
        for (int j = 0; j < 4; ++j) { const f32x4 o = v[j] * rstd * gv[j] + bv[j]; xr[64 * j] = o; u32x2 w; w.x = pk2(o[0], o[1]); w.y = pk2(o[2], o[3]); o8[64 * j] = w; }
    }
}
constexpr int HS_STRIDE = 272;
template <int PASS>
__device__ __forceinline__ void s5_tile(const bf16_t* proj, const bf16_t* Bb, const bf16_t* Cc, const float* lam, const float* Dv, float* E, bf16_t* zpre,
                                        float* ore, float* oim  , int b, int g, int tile, LAS unsigned char* wl, int lane) {
    const int fr = lane & 15, q4 = lane >> 4;
    const size_t tok0 = (size_t)b * SEQ + (size_t)tile * 64;
    const bf16x8 zero8 = (bf16x8){0, 0, 0, 0, 0, 0, 0, 0};
    bf16x8 af[4];
#pragma unroll
    for (int mt = 0; mt < 4; ++mt) { const int tau = 16 * (fr >> 2) + 4 * mt + (fr & 3);
        af[mt] = q4 < 2 ? *(const bf16x8*)(proj + (tok0 + tau) * INW + C_U + g * 16 + 8 * q4) : zero8; }
#pragma unroll 1
    for (int jh = 0; jh < 2; ++jh) {
        f32x4 acc[4][4];
#pragma unroll
        for (int nt = 0; nt < 4; ++nt) { const bf16x8 bfr = q4 < 2 ? *(const bf16x8*)(Bb + ((g * 8 + 4 * jh + nt) * 16 + fr) * 16 + 8 * q4) : zero8;
#pragma unroll
            for (int mt = 0; mt < 4; ++mt) acc[nt][mt] = MFMA16(af[mt], bfr, ((f32x4){0.f, 0.f, 0.f, 0.f})); }
        float lre[2], lim[2], l16r[2], l16i[2], l64r[2], l64i[2];
#pragma unroll
        for (int j = 0; j < 2; ++j) { const float* lp = lam + (g * 64 + 16 * (2 * jh + j) + fr) * 8; const f32x4 a = *(const f32x4*)lp; const f32x4 c = *(const f32x4*)(lp + 4);
            lre[j] = a[0]; lim[j] = a[1]; l16r[j] = a[2]; l16i[j] = a[3]; l64r[j] = c[0]; l64i[j] = c[1]; }
#pragma unroll
        for (int j = 0; j < 2; ++j) { float hr = 0.f, hi = 0.f;
#pragma unroll
            for (int mt = 0; mt < 4; ++mt)
#pragma unroll
                for (int r = 0; r < 4; ++r) { const float nr = lre[j] * hr - lim[j] * hi + acc[2 * j][mt][r], ni = lre[j] * hi + lim[j] * hr + acc[2 * j + 1][mt][r];
                    acc[2 * j][mt][r] = nr; acc[2 * j + 1][mt][r] = ni; hr = nr; hi = ni; } }
        float c0r[2] = {0.f, 0.f}, c0i[2] = {0.f, 0.f};
        if (PASS == 2) {
            const float* Eb = E + ((size_t)(b * 32) * 24 + g) * 128 + fr * 8 + 4 * jh;
            for (int k0 = 0; k0 < tile; k0 += 8) {
                f32x4 ev[8];
#pragma unroll
                for (int kk = 0; kk < 8; ++kk) { const int k = (k0 + kk < tile) ? k0 + kk : 0; ev[kk] = *(const f32x4*)(Eb + (size_t)k * 3072); }
#pragma unroll
                for (int kk = 0; kk < 8; ++kk) if (k0 + kk < tile) {
#pragma unroll
                    for (int j = 0; j < 2; ++j) { const float er = ev[kk][2 * j], ei = ev[kk][2 * j + 1];
                        const float nr = l64r[j] * c0r[j] - l64i[j] * c0i[j] + er, ni = l64r[j] * c0i[j] + l64i[j] * c0r[j] + ei; c0r[j] = nr; c0i[j] = ni; } }
            }
        }
        float cr[2], ci[2], endr[2], endi[2];
#pragma unroll
        for (int j = 0; j < 2; ++j) {
            const float er = acc[2 * j][3][3], ei = acc[2 * j + 1][3][3];
            float xr = c0r[j], xi = c0i[j]; cr[j] = xr; ci[j] = xi;
#pragma unroll
            for (int q = 0; q < 4; ++q) { const float eqr = __shfl(er, fr + 16 * q), eqi = __shfl(ei, fr + 16 * q);
                const float nr = l16r[j] * xr - l16i[j] * xi + eqr, ni = l16r[j] * xi + l16i[j] * xr + eqi; xr = nr; xi = ni;
                if (q + 1 < 4 && q4 == q + 1) { cr[j] = xr; ci[j] = xi; } }
            endr[j] = xr; endi[j] = xi;
        }
        if (PASS == 1) {
            if (q4 == 0) { float* Ep = E + ((size_t)(b * 32 + tile) * 24 + g) * 128 + fr * 8 + 4 * jh; *(f32x4*)Ep = (f32x4){endr[0], endi[0], endr[1], endi[1]}; }
        } else {
            if (tile == 31 && q4 == 0) {
#pragma unroll
                for (int j = 0; j < 2; ++j) { ore[(size_t)(b * 24 + g) * 64 + 16 * (2 * jh + j) + fr] = endr[j]; oim[(size_t)(b * 24 + g) * 64 + 16 * (2 * jh + j) + fr] = endi[j]; } }
#pragma unroll
            for (int j = 0; j < 2; ++j) { float wr_ = cr[j], wi_ = ci[j];
#pragma unroll
                for (int mt = 0; mt < 4; ++mt)
#pragma unroll
                    for (int r = 0; r < 4; ++r) { const float nr = lre[j] * wr_ - lim[j] * wi_, ni = lre[j] * wi_ + lim[j] * wr_; wr_ = nr; wi_ = ni;
                        const int tau = 16 * q4 + 4 * mt + r;
                        *(LAS unsigned*)(wl + tau * HS_STRIDE + (16 * (2 * jh + j) + fr) * 4) = pk2(acc[2 * j][mt][r] + wr_, acc[2 * j + 1][mt][r] + wi_); } }
        }
    }
    if (PASS == 1) return;
    LDS_WAIT();
    f32x4 y[4];
#pragma unroll
    for (int mt = 0; mt < 4; ++mt) y[mt] = (f32x4){0.f, 0.f, 0.f, 0.f};
#pragma unroll
    for (int ks = 0; ks < 4; ++ks) { const bf16x8 bfr = *(const bf16x8*)(Cc + (g * 16 + fr) * 128 + 32 * ks + 8 * q4);
#pragma unroll
        for (int mt = 0; mt < 4; ++mt) { const bf16x8 afr = *(const LAS bf16x8*)(wl + (16 * mt + fr) * HS_STRIDE + (32 * ks + 8 * q4) * 2); y[mt] = MFMA16(afr, bfr, y[mt]); } }
    LDS_WAIT();
    const float dv = Dv[g * 16 + fr];
#pragma unroll
    for (int mt = 0; mt < 4; ++mt)
#pragma unroll
        for (int r = 0; r < 4; ++r) { const size_t tok = tok0 + 16 * mt + 4 * q4 + r; const float uv = bf2f(proj[tok * INW + C_U + g * 16 + fr]);
            zpre[tok * 384 + g * 16 + fr] = (bf16_t)f2bf(gelu_tanh(y[mt][r] + dv * uv)); }
}
__device__ __forceinline__ float ret_log2g(int h) { return log2f(1.0f - exp2f(-5.0f - (float)h)); }
__device__ __forceinline__ void ret_kv_task(const bf16_t* proj, float* KV, int b, int h, int c, int lane) {
    const int fr = lane & 15, q4 = lane >> 4; const size_t tok0 = (size_t)b * SEQ + (size_t)c * 128; const float l2g = ret_log2g(h);
    f32x4 acc[4][4];
#pragma unroll
    for (int dt = 0; dt < 4; ++dt)
#pragma unroll
        for (int et = 0; et < 4; ++et) acc[dt][et] = (f32x4){0.f, 0.f, 0.f, 0.f};
    for (int ks = 0; ks < 4; ++ks) {
        const int j0 = 32 * ks + 8 * q4; float dec[8];
#pragma unroll
        for (int i = 0; i < 8; ++i) dec[i] = 0.125f * exp2f(l2g * (float)(127 - j0 - i));
        bf16x8 af[4], bfv[4];
#pragma unroll
        for (int t = 0; t < 4; ++t) {
#pragma unroll
            for (int i = 0; i < 8; ++i) { const bf16_t* rp = proj + (tok0 + j0 + i) * INW + h * 64 + 16 * t + fr;
                af[t][i] = (short)f2bf(bf2f(rp[C_RK]) * dec[i]); bfv[t][i] = (short)rp[C_RV]; } }
#pragma unroll
        for (int dt = 0; dt < 4; ++dt)
#pragma unroll
            for (int et = 0; et < 4; ++et) acc[dt][et] = MFMA16(af[dt], bfv[et], acc[dt][et]);
    }
    float* o = KV + ((size_t)((b * 4 + h) * 16 + c)) * 4096;
#pragma unroll
    for (int dt = 0; dt < 4; ++dt)
#pragma unroll
        for (int et = 0; et < 4; ++et)
#pragma unroll
            for (int r = 0; r < 4; ++r) o[(16 * dt + 4 * q4 + r) * 64 + 16 * et + fr] = acc[dt][et][r];
}
constexpr int VT_STRIDE = 272, ST_STRIDE = 144;
__device__ __forceinline__ void ret_out_task(const bf16_t* proj, const float* KV, bf16_t* mix, const float* gng, const float* gnb, float* pret  ,
                                             int b, int h, int c, LAS unsigned char* lds, int tid) {
    const int lane = tid & 63, wave = tid >> 6, fr = lane & 15, q4 = lane >> 4; const size_t tok0 = (size_t)b * SEQ + (size_t)c * 128;
    const float l2g = ret_log2g(h); const float cd = exp2f(l2g * 128.f);
    LAS unsigned char* Vt = lds; LAS unsigned char* St = lds + 64 * VT_STRIDE;
    { const float* kvb = KV + ((size_t)(b * 4 + h) * 16) * 4096; float s[8];
#pragma unroll
      for (int i = 0; i < 8; ++i) s[i] = 0.f;
      for (int cc = 0; cc < c; ++cc) {
#pragma unroll
          for (int i = 0; i < 8; ++i) s[i] = cd * s[i] + kvb[(size_t)cc * 4096 + tid + 512 * i]; }
#pragma unroll
      for (int i = 0; i < 8; ++i) { const int idx = tid + 512 * i, d = idx >> 6, e = idx & 63; *(LAS unsigned short*)(St + e * ST_STRIDE + d * 2) = (unsigned short)f2bf(s[i]); }
      if (c == 15) {
#pragma unroll
          for (int i = 0; i < 8; ++i) pret[(size_t)(b * 4 + h) * 4096 + tid + 512 * i] = cd * s[i] + kvb[(size_t)15 * 4096 + tid + 512 * i]; } }
#pragma unroll
    for (int i = 0; i < 2; ++i) { const int idx = tid + 512 * i, j = idx >> 3, e0 = (idx & 7) * 8; const u32x4 v = *(const u32x4*)(proj + (tok0 + j) * INW + C_RV + h * 64 + e0);
        const unsigned w[4] = {v.x, v.y, v.z, v.w};
#pragma unroll
        for (int k = 0; k < 4; ++k) { *(LAS unsigned short*)(Vt + (e0 + 2 * k) * VT_STRIDE + j * 2) = (unsigned short)(w[k] & 0xffffu); *(LAS unsigned short*)(Vt + (e0 + 2 * k + 1) * VT_STRIDE + j * 2) = (unsigned short)(w[k] >> 16); } }
    __syncthreads();
    const int it = wave;
    const size_t qtok = tok0 + 16 * it + fr;
    bf16x8 qf[2];
#pragma unroll
    for (int ks = 0; ks < 2; ++ks) qf[ks] = *(const bf16x8*)(proj + qtok * INW + C_RQ + h * 64 + 32 * ks + 8 * q4);
    f32x4 o1[4], o2[4];
#pragma unroll
    for (int et = 0; et < 4; ++et) { o1[et] = (f32x4){0.f, 0.f, 0.f, 0.f}; o2[et] = (f32x4){0.f, 0.f, 0.f, 0.f};
#pragma unroll
        for (int ks = 0; ks < 2; ++ks) { const bf16x8 a = *(const LAS bf16x8*)(St + (16 * et + fr) * ST_STRIDE + (32 * ks + 8 * q4) * 2); o2[et] = MFMA16(a, qf[ks], o2[et]); } }
    const int iq = 16 * it + fr;
    for (int jp = 0; jp <= (it >> 1); ++jp) {
        f32x4 sc[2];
#pragma unroll
        for (int tt = 0; tt < 2; ++tt) { const int jt = 2 * jp + tt; sc[tt] = (f32x4){0.f, 0.f, 0.f, 0.f};
            if (jt <= it) {
#pragma unroll
                for (int ks = 0; ks < 2; ++ks) { const bf16x8 kf = *(const bf16x8*)(proj + (tok0 + 16 * jt + fr) * INW + C_RK + h * 64 + 32 * ks + 8 * q4); sc[tt] = MFMA16(kf, qf[ks], sc[tt]); }
#pragma unroll
                for (int r = 0; r < 4; ++r) { const int diff = iq - (16 * jt + 4 * q4 + r); sc[tt][r] = diff >= 0 ? sc[tt][r] * 0.125f * exp2f(l2g * (float)diff) : 0.f; } } }
        bf16x8 pb; { const unsigned w0 = pk2(sc[0][0], sc[0][1]), w1 = pk2(sc[0][2], sc[0][3]), w2 = pk2(sc[1][0], sc[1][1]), w3 = pk2(sc[1][2], sc[1][3]);
            const u32x4 pw = (u32x4){w0, w1, w2, w3}; pb = __builtin_bit_cast(bf16x8, pw); }
#pragma unroll
        for (int et = 0; et < 4; ++et) { const LAS unsigned char* vp = Vt + (16 * et + fr) * VT_STRIDE + (32 * jp + 4 * q4) * 2;
            const u32x2 a0 = *(const LAS u32x2*)vp, a1 = *(const LAS u32x2*)(vp + 32); const u32x4 aw = (u32x4){a0.x, a0.y, a1.x, a1.y};
            o1[et] = MFMA16(__builtin_bit_cast(bf16x8, aw), pb, o1[et]); }
    }
    const float idec = exp2f(l2g * (float)(iq + 1)); float v[4][4]; float s = 0.f;
#pragma unroll
    for (int et = 0; et < 4; ++et)
#pragma unroll
        for (int r = 0; r < 4; ++r) { v[et][r] = o1[et][r] + o2[et][r] * idec; s += v[et][r]; }
    s += __shfl_xor(s, 16); s += __shfl_xor(s, 32); const float mean = s * (1.f / 64.f); float s2 = 0.f;
#pragma unroll
    for (int et = 0; et < 4; ++et)
#pragma unroll
        for (int r = 0; r < 4; ++r) { v[et][r] -= mean; s2 += v[et][r] * v[et][r]; }
    s2 += __shfl_xor(s2, 16); s2 += __shfl_xor(s2, 32); const float rstd = 1.f / sqrtf(s2 * (1.f / 64.f) + LN_EPS);
#pragma unroll
    for (int et = 0; et < 4; ++et) { const int e = h * 64 + 16 * et + 4 * q4; const f32x4 gg = *(const f32x4*)(gng + e), bb = *(const f32x4*)(gnb + e);
        const u32x2 rgw = *(const u32x2*)(proj + qtok * INW + C_RG + e);
        const float g0 = bflo(rgw.x), g1 = bfhi(rgw.x), g2 = bflo(rgw.y), g3 = bfhi(rgw.y);
        u32x2 w; w.x = pk2(siluf_(g0) * (v[et][0] * rstd * gg[0] + bb[0]), siluf_(g1) * (v[et][1] * rstd * gg[1] + bb[1]));
        w.y = pk2(siluf_(g2) * (v[et][2] * rstd * gg[2] + bb[2]), siluf_(g3) * (v[et][3] * rstd * gg[3] + bb[3]));
        *(u32x2*)(mix + qtok * 1024 + 384 + e) = w; }
    __syncthreads();
}
constexpr int AVT_STRIDE = 544;
__device__ __forceinline__ float alibi_slope(int hq) { return hq == 0 ? 0.25f : hq == 1 ? 0.0625f : hq == 2 ? 0.015625f : hq == 3 ? 0.00390625f : hq == 4 ? 0.5f : 0.125f; }
__device__ __forceinline__ void swa_task(const bf16_t* proj, bf16_t* mix, const float* sinks, int b, int nb, int kvh, LAS unsigned char* lds, int tid) {
    const int lane = tid & 63, wave = tid >> 6, fr = lane & 15, q4 = lane >> 4;
    const long ftok0 = (long)b * SEQ + (long)(nb - 1) * 128;
    LAS unsigned char* Vt = lds;
#pragma unroll
    for (int i = 0; i < 4; ++i) { const int idx = tid + 512 * i, key = idx >> 3, d0 = (idx & 7) * 8; u32x4 v = (u32x4){0u, 0u, 0u, 0u};
        if (nb > 0 || key >= 128) v = *(const u32x4*)(proj + (size_t)(ftok0 + key) * INW + C_AV + kvh * 64 + d0);
        const unsigned w[4] = {v.x, v.y, v.z, v.w};
#pragma unroll
        for (int k = 0; k < 4; ++k) { *(LAS unsigned short*)(Vt + (d0 + 2 * k) * AVT_STRIDE + key * 2) = (unsigned short)(w[k] & 0xffffu); *(LAS unsigned short*)(Vt + (d0 + 2 * k + 1) * AVT_STRIDE + key * 2) = (unsigned short)(w[k] >> 16); } }
    __syncthreads();
    const int qt = wave; const size_t qtok = (size_t)(ftok0 + 128 + 16 * qt + fr);
#pragma unroll 1
    for (int g3 = 0; g3 < 3; ++g3) {
        const int hq = kvh * 3 + g3; const float slope = alibi_slope(hq), sink = sinks[hq];
        bf16x8 qf[2];
#pragma unroll
        for (int ks = 0; ks < 2; ++ks) qf[ks] = *(const bf16x8*)(proj + qtok * INW + C_AQ + hq * 64 + 32 * ks + 8 * q4);
        f32x4 o[4];
#pragma unroll
        for (int dt = 0; dt < 4; ++dt) o[dt] = (f32x4){0.f, 0.f, 0.f, 0.f};
        float mrun = sink, den = 0.f;
#pragma unroll 1
        for (int mp = 0; mp < 5; ++mp) {
            f32x4 s2[2]; float mx = -1e30f;
#pragma unroll
            for (int tt = 0; tt < 2; ++tt) { const int kt = 2 * mp + tt, T = qt + kt; s2[tt] = (f32x4){0.f, 0.f, 0.f, 0.f};
                const bool live = kt < 9 && (nb > 0 || T >= 8);
                if (live) {
#pragma unroll
                    for (int ks = 0; ks < 2; ++ks) { const bf16x8 kf = *(const bf16x8*)(proj + (size_t)(ftok0 + 16 * T + fr) * INW + C_AK + kvh * 64 + 32 * ks + 8 * q4); s2[tt] = MFMA16(kf, qf[ks], s2[tt]); } }
#pragma unroll
                for (int r = 0; r < 4; ++r) { const int dist = 128 - 16 * kt + fr - 4 * q4 - r; const bool ok = live && dist >= 0 && dist <= 128;
                    const float v = ok ? s2[tt][r] * 0.125f - slope * (float)dist : -1e30f; s2[tt][r] = v; mx = fmaxf(mx, v); } }
            mx = fmaxf(mx, __shfl_xor(mx, 16)); mx = fmaxf(mx, __shfl_xor(mx, 32));
            const float mnew = fmaxf(mrun, mx), scale = __expf(mrun - mnew); mrun = mnew; den *= scale;
#pragma unroll
            for (int tt = 0; tt < 2; ++tt)
#pragma unroll
                for (int r = 0; r < 4; ++r) { const float e = s2[tt][r] > -1e29f ? __expf(s2[tt][r] - mnew) : 0.f; s2[tt][r] = e; den += e; }
            const u32x4 pw = (u32x4){pk2(s2[0][0], s2[0][1]), pk2(s2[0][2], s2[0][3]), pk2(s2[1][0], s2[1][1]), pk2(s2[1][2], s2[1][3])};
            const bf16x8 pb = __builtin_bit_cast(bf16x8, pw); const int T0 = qt + 2 * mp;
#pragma unroll
            for (int dt = 0; dt < 4; ++dt) { const LAS unsigned char* vp = Vt + (16 * dt + fr) * AVT_STRIDE + (16 * T0 + 4 * q4) * 2;
                const u32x2 a0 = *(const LAS u32x2*)vp; u32x2 a1 = (u32x2){0u, 0u}; if (mp < 4) a1 = *(const LAS u32x2*)(vp + 32);
                const u32x4 aw = (u32x4){a0.x, a0.y, a1.x, a1.y}; o[dt] = MFMA16(__builtin_bit_cast(bf16x8, aw), pb, o[dt] * scale); }
        }
        den += __shfl_xor(den, 16); den += __shfl_xor(den, 32); den += __expf(sink - mrun);
        const float inv = 1.f / den;
#pragma unroll
        for (int dt = 0; dt < 4; ++dt) { u32x2 w; w.x = pk2(o[dt][0] * inv, o[dt][1] * inv); w.y = pk2(o[dt][2] * inv, o[dt][3] * inv);
            *(u32x2*)(mix + qtok * 1024 + 640 + hq * 64 + 16 * dt + 4 * q4) = w; }
    }
    __syncthreads();
}
__device__ __forceinline__ void sample_task(const Params& P, int l, int s, const bf16_t* proj, const bf16_t* Bb, const float* lam, bf16_t* zpre, bf16_t* mix, LAS unsigned char* lds, int tid) {
    const int lane = tid & 63, wave = tid >> 6;
    LAS float* pr = (LAS float*)lds;
    LAS float* hst = pr + 2048;
    LAS float* red = hst + 3072;
    LAS float* sc = red + 512 + 16;
    const size_t row = (size_t)MP + s;
    float* out = P.out;
#pragma unroll
    for (int i = 0; i < 4; ++i) { const int c = tid + 512 * i; pr[c] = bf2f(proj[row * INW + c]); }
    __syncthreads();
#pragma unroll
    for (int i = 0; i < 3; ++i) { const int idx = tid + 512 * i, g = idx >> 6, p = idx & 63; const size_t si = ((size_t)(l * 128 + s) * 24 + g) * 64 + p;
        const float h0r = P.in[2][si], h0i = P.in[3][si]; const float lr = lam[(g * 64 + p) * 8], li = lam[(g * 64 + p) * 8 + 1];
        const bf16_t* br = Bb + ((g * 8 + 2 * (p >> 4)) * 16 + (p & 15)) * 16; const bf16_t* bi = br + 256;
        float hr = lr * h0r - li * h0i, hi = lr * h0i + li * h0r;
#pragma unroll
        for (int h = 0; h < 16; ++h) { const float u = pr[C_U + g * 16 + h]; hr += bf2f(br[h]) * u; hi += bf2f(bi[h]) * u; }
        out[O_SSRE + si] = hr; out[O_SSIM + si] = hi; hst[idx * 2] = hr; hst[idx * 2 + 1] = hi; }
    __syncthreads();
    if (tid < 384) { const int g = tid >> 4, hh = tid & 15; const float* cre = P.in[13] + ((size_t)(l * 24 + g) * 16 + hh) * 64; const float* cim = P.in[14] + ((size_t)(l * 24 + g) * 16 + hh) * 64;
        float y = 0.f;
#pragma unroll 4
        for (int p = 0; p < 64; ++p) y += cre[p] * hst[(g * 64 + p) * 2] - cim[p] * hst[(g * 64 + p) * 2 + 1];
        y += P.in[15][l * 384 + tid] * pr[C_U + tid];
        zpre[row * 384 + tid] = (bf16_t)f2bf(gelu_tanh(y)); }
    { const int h = tid >> 7, e = tid & 63, dh = (tid >> 6) & 1; const float gam = 1.0f - exp2f(-5.0f - (float)h);
      const size_t sb = ((size_t)(l * 128 + s) * 4 + h) * 4096; const float ve = pr[C_RV + h * 64 + e];
      float part = 0.f, qk = 0.f;
#pragma unroll 4
      for (int dd = 0; dd < 32; ++dd) { const int d = 32 * dh + dd; const float s0 = P.in[4][sb + d * 64 + e], q = pr[C_RQ + h * 64 + d], k = pr[C_RK + h * 64 + d] * 0.125f;
          out[O_SRET + sb + d * 64 + e] = gam * s0 + k * ve; part += q * s0; qk += q * k; }
      red[(h * 2 + dh) * 64 + e] = part; if (e == 0) red[512 + h * 2 + dh] = qk;
      __syncthreads();
      if (dh == 0) { const float o = (red[512 + h * 2] + red[512 + h * 2 + 1]) * ve + gam * (red[(h * 2) * 64 + e] + red[(h * 2 + 1) * 64 + e]);
          const float mean = wave_sum(o) * (1.f / 64.f); const float dlt = o - mean; const float var = wave_sum(dlt * dlt) * (1.f / 64.f); const float nrm = dlt / sqrtf(var + LN_EPS);
          const float val = siluf_(pr[C_RG + h * 64 + e]) * (nrm * P.in[18][l * 256 + h * 64 + e] + P.in[19][l * 256 + h * 64 + e]);
          mix[row * 1024 + 384 + h * 64 + e] = (bf16_t)f2bf(val); } }
    const float* ck = P.in[5] + (size_t)(l * 128 + s) * 16384; const float* cv = P.in[6] + (size_t)(l * 128 + s) * 16384;
    for (int idx = tid; idx < 6 * 129; idx += 512) { const int hq = idx / 129, j = idx % 129, kvh = hq / 3; float dot = 0.f;
        if (j < 128) { const float* kp = ck + j * 128 + kvh * 64;
#pragma unroll 8
            for (int d = 0; d < 64; ++d) dot += pr[C_AQ + hq * 64 + d] * kp[d]; }
        else {
#pragma unroll 8
            for (int d = 0; d < 64; ++d) dot += pr[C_AQ + hq * 64 + d] * pr[C_AK + kvh * 64 + d]; }
        sc[hq * 132 + j] = dot * 0.125f - alibi_slope(hq) * (float)(128 - j); }
    __syncthreads();
    if (wave < 6) { const int hq = wave; const float sink = P.in[20][l * 6 + hq]; float mx = sink;
        for (int j = lane; j < 129; j += 64) mx = fmaxf(mx, sc[hq * 132 + j]);
#pragma unroll
        for (int o = 1; o < 64; o <<= 1) mx = fmaxf(mx, __shfl_xor(mx, o));
        float den = 0.f;
        for (int j = lane; j < 129; j += 64) { const float e = __expf(sc[hq * 132 + j] - mx); sc[hq * 132 + j] = e; den += e; }
        den = wave_sum(den) + __expf(sink - mx); const float inv = 1.f / den;
        for (int j = lane; j < 129; j += 64) sc[hq * 132 + j] *= inv; }
    __syncthreads();
    if (tid < 384) { const int hq = tid >> 6, d = tid & 63, kvh = hq / 3; float o = 0.f;
#pragma unroll 8
        for (int j = 0; j < 128; ++j) o += sc[hq * 132 + j] * cv[j * 128 + kvh * 64 + d];
        o += sc[hq * 132 + 128] * pr[C_AV + kvh * 64 + d];
        mix[row * 1024 + 640 + hq * 64 + d] = (bf16_t)f2bf(o); }
    { float* ok = out + O_SWK + (size_t)(l * 128 + s) * 16384; float* ov = out + O_SWV + (size_t)(l * 128 + s) * 16384;
#pragma unroll 2
      for (int i = 0; i < 8; ++i) { const int q = tid + 512 * i, j = q >> 5, c4 = (q & 31) * 4;
          f32x4 a, b2;
          if (j < 127) { a = *(const f32x4*)(ck + (j + 1) * 128 + c4); b2 = *(const f32x4*)(cv + (j + 1) * 128 + c4); }
          else { a = (f32x4){pr[C_AK + c4], pr[C_AK + c4 + 1], pr[C_AK + c4 + 2], pr[C_AK + c4 + 3]}; b2 = (f32x4){pr[C_AV + c4], pr[C_AV + c4 + 1], pr[C_AV + c4 + 2], pr[C_AV + c4 + 3]}; }
          *(f32x4*)(ok + j * 128 + c4) = a; *(f32x4*)(ov + j * 128 + c4) = b2; } }
    __syncthreads();
}
template <int MODE>
__device__ __forceinline__ void sgemm_task(const bf16_t* A, const bf16_t* Bt, int K, int task, int lane,
                                           bf16_t* ob, const bf16_t* zin, const float* bias, const float* base, float* xres) {
    const int fr = lane & 15, q4 = lane >> 4; const int mh = task & 1, ns = task >> 1; const int col = 16 * ns + fr;
    const bf16_t* ap = A + (size_t)(64 * mh + fr) * K + 8 * q4;
    const int brow = MODE == 3 ? ((col >> 7) * 256 + (col & 127)) : col;
    const bf16_t* bp = Bt + (size_t)brow * K + 8 * q4;
    f32x4 acc[4], acc2[4];
#pragma unroll
    for (int mt = 0; mt < 4; ++mt) { acc[mt] = (f32x4){0.f, 0.f, 0.f, 0.f}; acc2[mt] = (f32x4){0.f, 0.f, 0.f, 0.f}; }
#pragma unroll 4
    for (int k0 = 0; k0 < K; k0 += 32) {
        const bf16x8 b = *(const bf16x8*)(bp + k0); bf16x8 b2; if (MODE == 3) b2 = *(const bf16x8*)(bp + (size_t)128 * K + k0);
#pragma unroll
        for (int mt = 0; mt < 4; ++mt) { const bf16x8 a = *(const bf16x8*)(ap + (size_t)(16 * mt) * K + k0); acc[mt] = MFMA16(a, b, acc[mt]); if (MODE == 3) acc2[mt] = MFMA16(a, b2, acc2[mt]); }
    }
#pragma unroll
    for (int mt = 0; mt < 4; ++mt)
#pragma unroll
        for (int r = 0; r < 4; ++r) { const size_t row = (size_t)MP + 64 * mh + 16 * mt + 4 * q4 + r; const float v = acc[mt][r];
            if (MODE == 0) ob[row * INW + col] = (bf16_t)f2bf(v);
            if (MODE == 1) ob[row * 1024 + col] = (bf16_t)f2bf(bf2f(zin[row * 384 + col]) * sigmoidf_(v + bias[col]));
            if (MODE == 2) { const float bs = base ? base[(row - MP) * 1024 + col] : xres[row * 1024 + col]; xres[row * 1024 + col] = bs * ALPHA + v; }
            if (MODE == 3) ob[row * FF + col] = (bf16_t)f2bf(siluf_(v) * acc2[mt][r]); }
}
__global__ void __launch_bounds__(512, 2) fwd_megakernel(Params P_) {
    extern __shared__ __attribute__((aligned(16))) unsigned char lds_raw[];
    LAS unsigned char* lds = (LAS unsigned char*)lds_raw;
    const int G0 = gridDim.x, bid0 = blockIdx.x;
    const int wave0 = __builtin_amdgcn_readfirstlane((int)threadIdx.x >> 6);
    if (threadIdx.x < 16) ((LAS unsigned*)(lds + LDS_BYTES - 64))[threadIdx.x] = 0u;
    __syncthreads();
    { const Params* pq = (const Params*)__builtin_amdgcn_kernarg_segment_ptr(); (void)xcd_barrier_post((unsigned*)(pq->ws) + 4096, (volatile LAS unsigned*)(lds + LDS_BYTES - 64)); }
#define GRID_BAR() do { const Params* pq = (const Params*)__builtin_amdgcn_kernarg_segment_ptr(); asm volatile("" : "+s"(pq)); XcdBarrier b_; b_.bar = (unsigned*)(pq->ws) + 4096; b_.x = xb_xcc_id(); \
        b_.st = (volatile LAS unsigned*)(lds + LDS_BYTES - 64); xcd_barrier(b_); } while (0)
#define FRESH_TID() int bid = bid0; asm volatile("" : "+s"(bid)); int G = G0; asm volatile("" : "+s"(G)); const int NGW = G * 8; (void)NGW; unsigned zz_ = 0u; asm volatile("" : "+v"(zz_)); int lane_ = (int)__builtin_amdgcn_mbcnt_hi(~0u, __builtin_amdgcn_mbcnt_lo(~0u, zz_)); const int lane = lane_, wave = wave0; const int tid = wave * 64 + lane; const int gw = bid * 8 + wave, gwr = (G - 1 - bid) * 8 + wave
#define PHASE_VARS() FRESH_TID(); const Params* pp = (const Params*)__builtin_amdgcn_kernarg_segment_ptr(); asm volatile("" : "+s"(pp)); const Params& P = *pp; \
    unsigned char* ws = P.ws; float* out = P.out; float* xres = out; \
    bf16_t* xb = (bf16_t*)(ws + OFF_XB); bf16_t* proj = (bf16_t*)(ws + OFF_PROJ); bf16_t* zpre = (bf16_t*)(ws + OFF_ZPRE); bf16_t* mix = (bf16_t*)(ws + OFF_MIX); bf16_t* hid = (bf16_t*)(ws + OFF_HID); \
    float* KV = (float*)(ws + OFF_KV); float* E = (float*)(ws + OFF_E); \
    unsigned char* wl = ws + OFF_W + (size_t)l * SZ_WL; \
    const bf16_t* WinT = (const bf16_t*)wl; const bf16_t* WoutT = (const bf16_t*)(wl + SZ_WIN); const bf16_t* W13T = (const bf16_t*)(wl + SZ_WIN + SZ_WOUT); \
    const bf16_t* W2T = (const bf16_t*)(wl + SZ_WIN + SZ_WOUT + SZ_W13); const bf16_t* GluT = (const bf16_t*)(wl + SZ_WIN + SZ_WOUT + SZ_W13 + SZ_W2); \
    const bf16_t* Bb = (const bf16_t*)(ws + OFF_S5C + (size_t)l * SZ_S5C); const bf16_t* Cc = (const bf16_t*)(ws + OFF_S5C + (size_t)l * SZ_S5C + SZ_BB); const float* lam = (const float*)(ws + OFF_S5C + (size_t)l * SZ_S5C + SZ_BB + SZ_CC); \
    (void)xres; (void)xb; (void)proj; (void)zpre; (void)mix; (void)hid; (void)KV; (void)E; (void)WinT; (void)WoutT; (void)W13T; (void)W2T; (void)GluT; (void)Bb; (void)Cc; (void)lam; (void)gw; (void)gwr; (void)lane; (void)wave
    { const int l = 0; PHASE_VARS(); phase0(P, lds, gw, NGW, wave, lane); }
    cg::this_grid().sync();

    for (int l = 0; l < 2; ++l) {
        { PHASE_VARS(); pg8::Gemm g{xb, WinT, MP, INW, 1024}; pg8::StaticOrder S; S.init(MP, INW, G, bid);
          EpiProj Ep{proj};
          pg8::gemm_phase<EpiProj, pg8::StaticOrder>(lds, g, S, Ep, tid); }
        { PHASE_VARS(); for (int t = wave * G + bid; t < 256; t += NGW) sgemm_task<0>(xb + (size_t)MP * 1024, WinT, 1024, t, lane, proj, nullptr, nullptr, nullptr, nullptr); }
        GRID_BAR();

        { PHASE_VARS();
        for (int i = gw * 64 + lane; i < 8 * 128 * 32; i += NGW * 64) { const int c8 = (i & 31) * 8, t = (i >> 5) & 127, b = i >> 12;
            const u32x4 v = *(const u32x4*)(proj + ((size_t)b * SEQ + 1920 + t) * INW + C_AK + c8); float* dst = out + (c8 < 128 ? O_PWK : O_PWV) + (size_t)l * 131072 + (size_t)(b * 128 + t) * 128 + (c8 & 127);
            *(f32x4*)dst = (f32x4){bflo(v.x), bfhi(v.x), bflo(v.y), bfhi(v.y)}; *(f32x4*)(dst + 4) = (f32x4){bflo(v.z), bfhi(v.z), bflo(v.w), bfhi(v.w)}; }
        for (int t = bid; t < 256; t += G) swa_task(proj, mix, P.in[20] + l * 6, t >> 5, (t >> 1) & 15, t & 1, lds, tid);
        for (int t = bid; t < 128; t += G) sample_task(P, l, t, proj, Bb, lam, zpre, mix, lds, tid);
        for (int t = gwr; t < 512 + 6144; t += NGW) {
            if (t < 512) ret_kv_task(proj, KV, t >> 6, (t >> 4) & 3, t & 15, lane);
            else { const int u = t - 512; const int tile = u & 31, bg = u >> 5; s5_tile<1>(proj, Bb, Cc, lam, nullptr, E, nullptr, nullptr, nullptr, bg / 24, bg % 24, tile, lds, lane); }
        }
        }
        GRID_BAR();

        { PHASE_VARS();
        for (int t = bid; t < 512; t += G) ret_out_task(proj, KV, mix, P.in[18] + l * 256, P.in[19] + l * 256, out + O_PRET + (size_t)l * 131072, t >> 6, (t >> 4) & 3, t & 15, lds, tid);
        for (int t = gwr; t < 6144; t += NGW) { const int tile = t & 31, bg = t >> 5;
            s5_tile<2>(proj, Bb, Cc, lam, P.in[15] + l * 384, E, zpre, out + O_PSRE + (size_t)l * 12288, out + O_PSIM + (size_t)l * 12288, bg / 24, bg % 24, tile, lds + wave * 17408, lane); }
        }
        GRID_BAR();

        { PHASE_VARS(); pg8::Gemm g{zpre, GluT, MP, 512, 384}; pg8::StaticOrder S; S.init(MP, 512, G, bid);
          EpiGlu Ep{zpre, mix, P.in[17] + l * 384};
          pg8::gemm_phase<EpiGlu, pg8::StaticOrder>(lds, g, S, Ep, tid); }
        { PHASE_VARS(); if (bid >= 128) for (int t = (bid - 128) * 8 + wave; t < 48; t += 1024) sgemm_task<1>(zpre + (size_t)MP * 384, GluT, 384, t, lane, mix, zpre, P.in[17] + l * 384, nullptr, nullptr); }
        GRID_BAR();

        { PHASE_VARS(); pg8::Gemm g{mix, WoutT, MP, 1024, 1024}; pg8::StaticOrder S; S.init(MP, 1024, G, bid);
          EpiResid Ep{P.in[0], l == 0 ? P.in[1] : nullptr, xres};
          pg8::gemm_phase<EpiResid, pg8::StaticOrder>(lds, g, S, Ep, tid); }
        { PHASE_VARS(); for (int t = wave * G + bid; t < 128; t += NGW) sgemm_task<2>(mix + (size_t)MP * 1024, WoutT, 1024, t, lane, nullptr, nullptr, nullptr, l == 0 ? P.in[1] : nullptr, xres); }
        GRID_BAR();
        { PHASE_VARS(); ln_phase(xres, xb, P.in[22] + l * 1024, P.in[23] + l * 1024, gw, NGW, lane); }
        GRID_BAR();

        { PHASE_VARS(); pg8::Gemm g{xb, W13T, MP, 5632, 1024}; pg8::StaticOrder S; S.init(MP, 5632, G, bid);
          EpiSwiglu Ep{hid};
          pg8::gemm_phase<EpiSwiglu, pg8::StaticOrder>(lds, g, S, Ep, tid); }
        { PHASE_VARS(); if (bid >= 128) for (int t = (bid - 128) * 8 + wave; t < 352; t += 1024) sgemm_task<3>(xb + (size_t)MP * 1024, W13T, 1024, t, lane, hid, nullptr, nullptr, nullptr, nullptr); }
        GRID_BAR();
        { PHASE_VARS(); pg8::Gemm g{hid, W2T, MP, 1024, FF}; pg8::StaticOrder S; S.init(MP, 1024, G, bid);
          EpiResid Ep{P.in[0], nullptr, xres};
          pg8::gemm_phase<EpiResid, pg8::StaticOrder>(lds, g, S, Ep, tid); }
        { PHASE_VARS(); for (int t = wave * G + bid; t < 128; t += NGW) sgemm_task<2>(hid + (size_t)MP * FF, W2T, FF, t, lane, nullptr, nullptr, nullptr, nullptr, xres); }
        GRID_BAR();
        { PHASE_VARS(); ln_phase(xres, xb, P.in[27] + l * 1024, P.in[28] + l * 1024, gw, NGW, lane); }
        GRID_BAR();
    }
}

extern "C" void kernel_launch(void* const* d_in, const int* in_sizes, int n_in, void* d_out, int out_size, void* d_ws, size_t ws_size, hipStream_t stream) {
    static int grid_blocks = 0;
    if (!grid_blocks) {
        int dev = 0, cus = 0, per_cu = 0;
        hipGetDevice(&dev);
        hipDeviceGetAttribute(&cus, hipDeviceAttributeMultiprocessorCount, dev);
        hipFuncSetAttribute((const void*)fwd_megakernel, hipFuncAttributeMaxDynamicSharedMemorySize, LDS_BYTES);
        hipOccupancyMaxActiveBlocksPerMultiprocessor(&per_cu, (const void*)fwd_megakernel, 512, LDS_BYTES);
        if (per_cu < 1) per_cu = 1;
        grid_blocks = cus * per_cu;
        if (ws_size < WS_END) { fprintf(stderr, "kernel_launch: workspace too small (%zu < %zu)\n", ws_size, (size_t)WS_END); }
    }
    (void)hipMemsetAsync(d_ws, 0, 1u << 20, stream);
    Params p{};
    for (int i = 0; i < 29; ++i) p.in[i] = (const float*)d_in[i];
    p.out = (float*)d_out; p.ws = (unsigned char*)d_ws;
    void* args[] = {&p};
    hipError_t e = hipLaunchCooperativeKernel((const void*)fwd_megakernel, dim3(grid_blocks), dim3(512), args, LDS_BYTES, stream);
    if (e != hipSuccess) fprintf(stderr, "cooperative launch failed: %s (grid %d)\n", hipGetErrorString(e), grid_blocks);
}
```
